# Optimizing an MI355X kernel written in HIP

```python
import jax, jax.numpy as jnp
from jax import lax
import numpy as np

D_MODEL = 1024
BATCH = 16
SEQ = 2048
DEPTH = 4

HEAD_DIM = 64
A_HEADS = 8
A_Q_RANK = 256
A_KV_RANK = 128
A_NOPE_DIM = 64
A_ROPE_DIM = 32
A_V_DIM = 64
B_HEADS = 8
B_BRANCHES = ((128, 1), (512, 4), (2048, 16))
C_HEADS = 16
GRID_W = 64
NA_ROWS = 8
NA_COLS = 16
NA_COL_BLOCK = 16
NA_BAND = NA_COL_BLOCK + NA_COLS
D_FF = -(-8 * D_MODEL // (3 * 256)) * 256

ROPE_THETA = 10000.0
EPS = 1e-6
Q_BLOCK = 128
NEG_INF = -1e30
N_EVEN = (DEPTH + 1) // 2
N_ODD = DEPTH // 2
EVEN_IN_COLS = A_Q_RANK + A_KV_RANK + A_ROPE_DIM + 3 * B_HEADS * HEAD_DIM
EVEN_OUT_ROWS = A_HEADS * A_V_DIM + B_HEADS * HEAD_DIM
ODD_WIDTH = C_HEADS * HEAD_DIM

kernel_name = "hybrid_mla_dilated_neighbourhood_encoder"


def rmsnorm(x, g):
    xf = x.astype(jnp.float32)
    y = xf * lax.rsqrt(jnp.mean(xf * xf, axis=-1, keepdims=True) + EPS)
    return (y * g.astype(jnp.float32)).astype(x.dtype)


def rope_tables(seq_len, dim):
    pos = jnp.arange(seq_len, dtype=jnp.float32)
    inv = ROPE_THETA ** (-jnp.arange(0, dim, 2, dtype=jnp.float32) / dim)
    ang = pos[:, None] * inv[None, :]
    return jnp.cos(ang), jnp.sin(ang)


def apply_rope(x, cos, sin):
    half = x.shape[-1] // 2
    shape = (x.shape[1],) + (1,) * (x.ndim - 3) + (half,)
    c = cos.reshape(shape).astype(x.dtype)
    s = sin.reshape(shape).astype(x.dtype)
    x1, x2 = x[..., :half], x[..., half:]
    return jnp.concatenate([x1 * c - x2 * s, x2 * c + x1 * s], axis=-1)


def softmax_with_lse(s):
    m = jnp.max(s, axis=-1, keepdims=True)
    e = jnp.exp(s - m)
    den = jnp.sum(e, axis=-1, keepdims=True)
    return e / den, (m + jnp.log(den))[..., 0]


def mla_attention(q_nope, q_pe, k_nope, k_pe, v):
    B, S, H, _ = q_nope.shape
    nb = S // Q_BLOCK
    scale = (A_NOPE_DIM + A_ROPE_DIM) ** -0.5

    def blocks(t):
        return t.reshape((B, nb, Q_BLOCK) + t.shape[2:]).swapaxes(0, 1)

    def one_block(args):
        qn, qp = args
        s = (jnp.einsum('bqhd,bkhd->bhqk', qn, k_nope)
             + jnp.einsum('bqhd,bkd->bhqk', qp, k_pe)).astype(jnp.float32) * scale
        p = jax.nn.softmax(s, axis=-1).astype(v.dtype)
        return jnp.einsum('bhqk,bkhd->bqhd', p, v)

    o = lax.map(one_block, (blocks(q_nope), blocks(q_pe)))
    return o.swapaxes(0, 1).reshape(B, S, H, v.shape[-1])


def banded_attention(q, k, v, half_window, scale):
    N, L, H, dh = q.shape
    blk = half_window
    nb = -(-L // blk)
    pad = nb * blk - L
    qb = jnp.pad(q, ((0, 0), (0, pad), (0, 0), (0, 0))).reshape(N, nb, blk, H, dh)

    def windows(t):
        tb = jnp.pad(t, ((0, 0), (blk, blk + pad), (0, 0), (0, 0))).reshape(N, nb + 2, blk, H, dh)
        return jnp.concatenate([tb[:, :-2], tb[:, 1:-1], tb[:, 2:]], axis=2)

    kw, vw = windows(k), windows(v)
    qpos = np.arange(nb)[:, None] * blk + np.arange(blk)[None, :]
    kpos = (np.arange(nb)[:, None] - 1) * blk + np.arange(3 * blk)[None, :]
    kp = kpos[:, None, :]
    valid = (np.abs(kp - qpos[:, :, None]) <= half_window) & (kp >= 0) & (kp < L)
    s = jnp.einsum('nbqhd,nbkhd->nbhqk', qb, kw).astype(jnp.float32) * scale
    s = jnp.where(valid[None, :, None], s, NEG_INF)
    p, lse = softmax_with_lse(s)
    o = jnp.einsum('nbhqk,nbkhd->nbqhd', p.astype(v.dtype), vw).reshape(N, nb * blk, H, dh)[:, :L]
    lse = lse.transpose(0, 1, 3, 2).reshape(N, nb * blk, H)[:, :L]
    return o, lse


def dilated_attention(q, k, v):
    B, S, H, dh = q.shape
    scale = dh ** -0.5
    outs, lses = [], []
    for window, dilation in B_BRANCHES:
        n_sub = S // dilation

        def to_sub(t):
            return t.reshape(B, n_sub, dilation, H, dh).swapaxes(1, 2).reshape(B * dilation, n_sub, H, dh)

        o, lse = banded_attention(to_sub(q), to_sub(k), to_sub(v), window // (2 * dilation), scale)
        outs.append(o.reshape(B, dilation, n_sub, H, dh).swapaxes(1, 2).reshape(B, S, H, dh))
        lses.append(lse.reshape(B, dilation, n_sub, H).swapaxes(1, 2).reshape(B, S, H))
    w = jax.nn.softmax(jnp.stack(lses), axis=0)
    return jnp.einsum('gbsh,gbshd->bshd', w.astype(q.dtype), jnp.stack(outs))


def neighbourhood_attention(q, k, v, rpb):
    B, S, H, dh = q.shape
    rows = S // GRID_W
    kr = min(NA_ROWS, rows)
    n_cb = GRID_W // NA_COL_BLOCK
    scale = dh ** -0.5
    r = np.arange(rows)
    row_start = np.clip(r - kr // 2, 0, rows - kr)
    row_off = row_start[:, None] + np.arange(kr)[None, :] - r[:, None] + (NA_ROWS - 1)
    qcol = np.arange(GRID_W).reshape(n_cb, NA_COL_BLOCK)
    col_start = np.clip(qcol - NA_COLS // 2, 0, GRID_W - NA_COLS)
    band_start = np.clip(np.arange(n_cb) * NA_COL_BLOCK - NA_COLS // 2, 0, GRID_W - NA_BAND)
    band_col = band_start[:, None] + np.arange(NA_BAND)[None, :]
    bc = band_col[:, None, :]
    col_valid = (bc >= col_start[..., None]) & (bc < col_start[..., None] + NA_COLS)
    col_off = np.clip(bc - qcol[..., None] + (NA_COLS - 1), 0, 2 * NA_COLS - 2)
    key_valid = np.broadcast_to(col_valid[:, :, None, :], (n_cb, NA_COL_BLOCK, kr, NA_BAND)).reshape(
        n_cb, NA_COL_BLOCK, kr * NA_BAND)
    kg = k.reshape(B, rows, GRID_W, H, dh)
    vg = v.reshape(B, rows, GRID_W, H, dh)
    qg = q.reshape(B, rows, GRID_W, H, dh).swapaxes(0, 1)

    def gather_band(t_rows):
        t = t_rows[:, :, band_col]
        return t.swapaxes(1, 2).reshape(B, n_cb, kr * NA_BAND, H, dh)

    def one_row(args):
        q_row, rs, ro = args
        k_band = gather_band(lax.dynamic_slice_in_dim(kg, rs, kr, axis=1))
        v_band = gather_band(lax.dynamic_slice_in_dim(vg, rs, kr, axis=1))
        q_blk = q_row.reshape(B, n_cb, NA_COL_BLOCK, H, dh)
        s = jnp.einsum('bjqhd,bjkhd->bhjqk', q_blk, k_band).astype(jnp.float32) * scale
        bias = rpb[:, ro[:, None, None, None], col_off[None]]
        bias = bias.transpose(0, 2, 3, 1, 4).reshape(H, n_cb, NA_COL_BLOCK, kr * NA_BAND)
        s = jnp.where(key_valid, s + bias.astype(jnp.float32), NEG_INF)
        p = jax.nn.softmax(s, axis=-1).astype(v.dtype)
        o = jnp.einsum('bhjqk,bjkhd->bjqhd', p, v_band)
        return o.reshape(B, GRID_W, H, dh)

    o = lax.map(one_row, (qg, jnp.asarray(row_start, jnp.int32), jnp.asarray(row_off, jnp.int32)))
    return o.swapaxes(0, 1).reshape(B, S, H, dh)


def even_mixer(h, w_in, q_norm, w_q_up, kv_norm, w_kv_up, w_out, cos_a, sin_a, cos_b, sin_b):
    B, S, _ = h.shape
    z = h @ w_in
    c_q, c_kv, k_pe, qkv_b = jnp.split(
        z, [A_Q_RANK, A_Q_RANK + A_KV_RANK, A_Q_RANK + A_KV_RANK + A_ROPE_DIM], axis=-1)
    q_a = (rmsnorm(c_q, q_norm) @ w_q_up).reshape(B, S, A_HEADS, A_NOPE_DIM + A_ROPE_DIM)
    q_nope = q_a[..., :A_NOPE_DIM]
    q_pe = apply_rope(q_a[..., A_NOPE_DIM:], cos_a, sin_a)
    kv = (rmsnorm(c_kv, kv_norm) @ w_kv_up).reshape(B, S, A_HEADS, A_NOPE_DIM + A_V_DIM)
    k_nope, v_a = kv[..., :A_NOPE_DIM], kv[..., A_NOPE_DIM:]
    k_pe = apply_rope(k_pe, cos_a, sin_a)
    o_a = mla_attention(q_nope, q_pe, k_nope, k_pe, v_a)
    qkv_b = qkv_b.reshape(B, S, 3, B_HEADS, HEAD_DIM)
    q_b = apply_rope(qkv_b[:, :, 0], cos_b, sin_b)
    k_b = apply_rope(qkv_b[:, :, 1], cos_b, sin_b)
    o_b = dilated_attention(q_b, k_b, qkv_b[:, :, 2])
    o = jnp.concatenate([o_a.reshape(B, S, A_HEADS * A_V_DIM), o_b.reshape(B, S, B_HEADS * HEAD_DIM)], axis=-1)
    return o @ w_out


def odd_mixer(h, w_qkv, rpb, w_out):
    B, S, _ = h.shape
    qkv = (h @ w_qkv).reshape(B, S, 3, C_HEADS, HEAD_DIM)
    o = neighbourhood_attention(qkv[:, :, 0], qkv[:, :, 1], qkv[:, :, 2], rpb)
    return o.reshape(B, S, ODD_WIDTH) @ w_out


def swiglu(h, w_gate, w_up, w_down):
    return (jax.nn.silu(h @ w_gate) * (h @ w_up)) @ w_down


def setup_inputs(seed: int = 0) -> dict:
    key = jax.random.key(seed)
    ks = jax.random.split(key, 20)
    f32 = jnp.float32

    def w(k, shape, fan_in):
        return jax.random.normal(k, shape, f32) * fan_in ** -0.5

    def gain(k, shape):
        return 1.0 + 0.05 * jax.random.normal(k, shape, f32)

    return {
        "x": jax.random.normal(ks[0], (BATCH, SEQ, D_MODEL), f32),
        "ev_norm": gain(ks[1], (N_EVEN, D_MODEL)),
        "ev_w_in": w(ks[2], (N_EVEN, D_MODEL, EVEN_IN_COLS), D_MODEL),
        "ev_q_norm": gain(ks[3], (N_EVEN, A_Q_RANK)),
        "ev_w_q_up": w(ks[4], (N_EVEN, A_Q_RANK, A_HEADS * (A_NOPE_DIM + A_ROPE_DIM)), A_Q_RANK),
        "ev_kv_norm": gain(ks[5], (N_EVEN, A_KV_RANK)),
        "ev_w_kv_up": w(ks[6], (N_EVEN, A_KV_RANK, A_HEADS * (A_NOPE_DIM + A_V_DIM)), A_KV_RANK),
        "ev_w_out": w(ks[7], (N_EVEN, EVEN_OUT_ROWS, D_MODEL), EVEN_OUT_ROWS),
        "od_norm": gain(ks[8], (N_ODD, D_MODEL)),
        "od_w_qkv": w(ks[9], (N_ODD, D_MODEL, 3 * ODD_WIDTH), D_MODEL),
        "od_rpb": 0.02 * jax.random.normal(ks[10], (N_ODD, C_HEADS, 2 * NA_ROWS - 1, 2 * NA_COLS - 1), f32),
        "od_w_out": w(ks[11], (N_ODD, ODD_WIDTH, D_MODEL), ODD_WIDTH),
        "ffn_norm": gain(ks[12], (DEPTH, D_MODEL)),
        "ffn_w_gate": w(ks[13], (DEPTH, D_MODEL, D_FF), D_MODEL),
        "ffn_w_up": w(ks[14], (DEPTH, D_MODEL, D_FF), D_MODEL),
        "ffn_w_down": w(ks[15], (DEPTH, D_FF, D_MODEL), D_FF),
        "final_norm": gain(ks[16], (D_MODEL,)),
    }


def reference(x, ev_norm, ev_w_in, ev_q_norm, ev_w_q_up, ev_kv_norm, ev_w_kv_up, ev_w_out,
              od_norm, od_w_qkv, od_rpb, od_w_out,
              ffn_norm, ffn_w_gate, ffn_w_up, ffn_w_down, final_norm):
    S = x.shape[1]
    cos_a, sin_a = rope_tables(S, A_ROPE_DIM)
    cos_b, sin_b = rope_tables(S, HEAD_DIM)
    h = x
    for layer in range(DEPTH):
        i = layer // 2
        if layer % 2 == 0:
            h = h + even_mixer(rmsnorm(h, ev_norm[i]), ev_w_in[i], ev_q_norm[i], ev_w_q_up[i],
                               ev_kv_norm[i], ev_w_kv_up[i], ev_w_out[i], cos_a, sin_a, cos_b, sin_b)
        else:
            h = h + odd_mixer(rmsnorm(h, od_norm[i]), od_w_qkv[i], od_rpb[i], od_w_out[i])
        h = h + swiglu(rmsnorm(h, ffn_norm[layer]), ffn_w_gate[layer], ffn_w_up[layer], ffn_w_down[layer])
    return rmsnorm(h, final_norm)
```

```cpp
#include <hip/hip_runtime.h>
#include <hip/hip_cooperative_groups.h>
#include <cstdio>
#include <cstdint>
namespace cg = cooperative_groups;
namespace pg8 {
#define PG8_LAS __attribute__((address_space(3)))
typedef unsigned short bf16_t;
typedef short bf16x8 __attribute__((ext_vector_type(8)));
typedef float f32x4 __attribute__((ext_vector_type(4)));
typedef unsigned u32x4 __attribute__((ext_vector_type(4)));
constexpr int BM = 256, BK = 64, HALF = 128, HTB = HALF * BK * 2  , STAGE_BYTES = 8 * HTB, NXCD = 8, WGM = 8;

__host__ __device__ __forceinline__ int lds_byte(int r, int c) { const int st = (r >> 4) * 2 + (c >> 5), rr = r & 15, cc = c & 31, ob = rr * 64 + cc * 2; return st * 1024 + (ob ^ (((ob >> 9) & 1) << 5)); }
__host__ __device__ __forceinline__ void stage_rc(int b, int& R, int& C) { const int st = b / 1024, sb = b % 1024, swz = sb ^ (((sb >> 9) & 1) << 5); R = (st >> 1) * 16 + swz / 64; C = (st & 1) * 32 + (swz % 64) / 2; }
__host__ __device__ __forceinline__ int perm32(int rho) { const int n = rho >> 4, i = rho & 15; return 8 * (i >> 2) + 4 * n + (i & 3); }

struct Unit { int pm, pn; };
struct Gemm { const bf16_t* A; const bf16_t* Bt; int M, N, K; };

struct StaticOrder {
    int nM, nN, nwg, G, c;
    __host__ __device__ void init(int M, int N, int G_, int c_) { nM = M / BM; nN = N / BM; nwg = nM * nN; G = G_; c = c_; }
    __host__ __device__ bool next(int i, Unit& u) const {
        const long L = (long)i * G + c; if (L >= nwg) return false;
        int wgid = (int)L; { const int q = nwg / NXCD, r = nwg % NXCD, xcd = wgid % NXCD, off = wgid / NXCD; wgid = (xcd < r ? xcd * (q + 1) : r * (q + 1) + (xcd - r) * q) + off; }
        const int nig = WGM * nN, gid = wgid / nig, fm = gid * WGM, gsz = (nM - fm) < WGM ? (nM - fm) : WGM;
        u.pm = fm + ((wgid % nig) % gsz); u.pn = (wgid % nig) / gsz; return true;
    }
    __device__ __forceinline__ void a_ready(const Unit&) const {}
    __device__ __forceinline__ void done(const Unit&) const {}
};
template <class Epi, class Sched, bool STAMP = false>
__device__ __forceinline__ void gemm_phase(PG8_LAS unsigned char* lds, const Gemm g, const Sched& S, const Epi& E, unsigned long long* stamps, int tid_in) {
    int tid_l = tid_in; asm volatile("" : "+v"(tid_l));
    const int tid = tid_l, wid = __builtin_amdgcn_readfirstlane(tid >> 6), lane = tid & 63, wr = wid >> 2, wc = wid & 3, fr = lane & 15, fq = lane >> 4;
    const int K = g.K, nt = K / BK;
    int ts_lo = 0, ts_hi = 0, nts = 0; const unsigned long long rt_entry = STAMP ? (unsigned long long)wall_clock64() : 0ull;
#define PG8_STAMP() do { if (STAMP && wid == 0 && nts < 64) { const unsigned long long _c = (unsigned long long)clock64(); \
        ts_lo = (lane == nts) ? (int)(unsigned)_c : ts_lo; ts_hi = (lane == nts) ? (int)(unsigned)(_c >> 32) : ts_hi; ++nts; } } while (0)
    PG8_STAMP();
    unsigned voffA[2], voffB[2];
#pragma unroll
    for (int i = 0; i < 2; ++i) { int R, C; stage_rc(tid * 16 + i * 8192, R, C); const int Rb = Epi::PERM ? ((R & ~31) + perm32(R & 31)) : R;
        voffA[i] = (unsigned)(R * K + C) * 2u; voffB[i] = (unsigned)(Rb * K + C) * 2u; }
    const size_t kstep = (size_t)(BK * 2);
    const size_t hstep = (size_t)HALF * K * 2;
    const size_t tstep = 2 * hstep;
    const unsigned ldsw = (unsigned)wid * 1024u;
    const int aoff = lds_byte(wr * 64 + fr, fq * 8), boff = lds_byte(wc * 32 + fr, fq * 8);
#define PG8_SA(b, h) (((b) * 2 + (h)) * HTB)
#define PG8_SB(b, h) ((4 + (b) * 2 + (h)) * HTB)
#define PG8_STAGE(bufoff, gbase, voff) do { _Pragma("unroll") for (int _i = 0; _i < 2; ++_i) \
        __builtin_amdgcn_global_load_lds((const unsigned*)((const char*)(gbase) + (voff)[_i]), (PG8_LAS unsigned*)(lds + (bufoff) + ldsw + _i * 8192), 16, 0, 0); } while (0)
#define PG8_LDA(dst, b, h) do { _Pragma("unroll") for (int m = 0; m < 4; ++m) _Pragma("unroll") for (int k = 0; k < 2; ++k) dst[m][k] = *(const PG8_LAS bf16x8*)(lds + PG8_SA(b, h) + aoff + m * 2048 + k * 1024); } while (0)
#define PG8_LDB(dst, b, h) do { _Pragma("unroll") for (int n = 0; n < 2; ++n) _Pragma("unroll") for (int k = 0; k < 2; ++k) dst[n][k] = *(const PG8_LAS bf16x8*)(lds + PG8_SB(b, h) + boff + n * 2048 + k * 1024); } while (0)
#define PG8_MMA(ai, bj, At, Bt) do { __builtin_amdgcn_s_setprio(1); _Pragma("unroll") for (int m = 0; m < 4; ++m) _Pragma("unroll") for (int n = 0; n < 2; ++n) _Pragma("unroll") for (int k = 0; k < 2; ++k) \
        acc[ai][bj][m][n] = __builtin_amdgcn_mfma_f32_16x16x32_bf16(Bt[n][k], At[m][k], acc[ai][bj][m][n], 0, 0, 0); __builtin_amdgcn_s_setprio(0); } while (0)
#define PG8_WAIT_V(n) asm volatile("s_waitcnt vmcnt(" #n ")" ::: "memory")
#define PG8_WAIT_L(n) asm volatile("s_waitcnt lgkmcnt(" #n ")" ::: "memory")
#define PG8_BAR __builtin_amdgcn_s_barrier()
#define PG8_SCHED __builtin_amdgcn_sched_barrier(0)
    Unit cur, nxt; int ui = 0;
    if (!S.next(0, cur)) return;
    f32x4 acc[2][2][4][2];
#pragma unroll
    for (int a = 0; a < 2; ++a)
#pragma unroll
        for (int b = 0; b < 2; ++b)
#pragma unroll
            for (int m = 0; m < 4; ++m)
#pragma unroll
                for (int n = 0; n < 2; ++n) acc[a][b][m][n] = (f32x4){0.f, 0.f, 0.f, 0.f};
    bf16x8 At[4][2], B0[2][2], B1[2][2];
    const char* cA = (const char*)g.A + (size_t)cur.pm * tstep; const char* cB = (const char*)g.Bt + (size_t)cur.pn * tstep;
    S.a_ready(cur);
    PG8_STAGE(PG8_SB(0, 0), cB, voffB); PG8_STAGE(PG8_SA(0, 0), cA, voffA); PG8_STAGE(PG8_SB(0, 1), cB + hstep, voffB); PG8_STAGE(PG8_SA(0, 1), cA + hstep, voffA);
    if (wr == 1) PG8_BAR;
    PG8_WAIT_V(4); PG8_BAR;
    PG8_STAGE(PG8_SB(1, 0), cB + kstep, voffB); PG8_STAGE(PG8_SA(1, 0), cA + kstep, voffA); PG8_STAGE(PG8_SB(1, 1), cB + hstep + kstep, voffB);
    PG8_WAIT_V(6); PG8_BAR;
    PG8_STAMP();
    for (;;) {
        const bool has_next = S.next(ui + 1, nxt);
        const char* nA = has_next ? (const char*)g.A + (size_t)nxt.pm * tstep : cA; const char* nB = has_next ? (const char*)g.Bt + (size_t)nxt.pn * tstep : cB;
        for (int t = 0; t < nt; t += 2) {
            const bool last = (t == nt - 2);
            const char* a1 = cA + (size_t)(t + 1) * kstep;
            const char* a2 = last ? nA : cA + (size_t)(t + 2) * kstep; const char* b2 = last ? nB : cB + (size_t)(t + 2) * kstep;
            const char* a3 = a2 + kstep; const char* b3 = b2 + kstep;
            if (last && has_next) S.a_ready(nxt);
            PG8_LDB(B0, 0, 0); PG8_SCHED; PG8_LDA(At, 0, 0); PG8_STAGE(PG8_SA(1, 1), a1 + hstep, voffA);
            PG8_WAIT_L(8); PG8_BAR; PG8_WAIT_L(0); PG8_MMA(0, 0, At, B0); PG8_BAR; PG8_SCHED;
            PG8_LDB(B1, 0, 1); PG8_STAGE(PG8_SB(0, 0), b2, voffB);
            PG8_BAR; PG8_WAIT_L(0); PG8_MMA(0, 1, At, B1); PG8_BAR;
            PG8_LDA(At, 0, 1); PG8_STAGE(PG8_SA(0, 0), a2, voffA);
            PG8_BAR; PG8_WAIT_L(0); PG8_MMA(1, 0, At, B0); PG8_BAR; PG8_SCHED;
            PG8_STAGE(PG8_SB(0, 1), b2 + hstep, voffB);
            PG8_WAIT_V(6); PG8_BAR; PG8_MMA(1, 1, At, B1); PG8_BAR;
            PG8_LDB(B0, 1, 0); PG8_SCHED; PG8_LDA(At, 1, 0); PG8_STAGE(PG8_SA(0, 1), a2 + hstep, voffA);
            PG8_WAIT_L(8); PG8_BAR; PG8_WAIT_L(0); PG8_MMA(0, 0, At, B0); PG8_BAR; PG8_SCHED;
            PG8_LDB(B1, 1, 1); PG8_STAGE(PG8_SB(1, 0), b3, voffB);
            PG8_BAR; PG8_WAIT_L(0); PG8_MMA(0, 1, At, B1); PG8_BAR;
            PG8_LDA(At, 1, 1); PG8_STAGE(PG8_SA(1, 0), a3, voffA);
            PG8_BAR; PG8_WAIT_L(0); PG8_MMA(1, 0, At, B0); PG8_BAR; PG8_SCHED;
            PG8_STAGE(PG8_SB(1, 1), b3 + hstep, voffB);
            PG8_WAIT_V(6); PG8_BAR; PG8_MMA(1, 1, At, B1); PG8_BAR;
        }
        PG8_STAMP();
        if constexpr (!Epi::AFTER_DRAIN) { E(acc, cur, wr, wc, fr, fq); S.done(cur); }
        PG8_STAMP();
        if (!has_next) break;
#pragma unroll
        for (int a = 0; a < 2; ++a)
#pragma unroll
            for (int b = 0; b < 2; ++b)
#pragma unroll
                for (int m = 0; m < 4; ++m)
#pragma unroll
                    for (int n = 0; n < 2; ++n) acc[a][b][m][n] = (f32x4){0.f, 0.f, 0.f, 0.f};
        cur = nxt; cA = nA; cB = nB; ++ui;
    }
    PG8_WAIT_V(0);
    if (wr == 0) PG8_BAR;
    PG8_BAR;
    if constexpr (Epi::AFTER_DRAIN) { E.fused(acc, cur, wr, wc, fr, fq, lds, wid, lane); S.done(cur); }
    PG8_STAMP();
    if (STAMP && wid == 0) { stamps[lane] = lane < nts ? (((unsigned long long)(unsigned)ts_hi << 32) | (unsigned)ts_lo) : 0ull;
        if (lane == 62) stamps[62] = rt_entry; if (lane == 63) stamps[63] = (unsigned long long)wall_clock64(); }
#undef PG8_STAMP
#undef PG8_SA
#undef PG8_SB
#undef PG8_STAGE
#undef PG8_LDA
#undef PG8_LDB
#undef PG8_MMA
#undef PG8_WAIT_V
#undef PG8_WAIT_L
#undef PG8_BAR
#undef PG8_SCHED
}
}

using pg8::bf16_t;
using pg8::f32x4;
using pg8::u32x4;
using pg8::Unit;
typedef short bf16x8 __attribute__((ext_vector_type(8)));
typedef float f32x16 __attribute__((ext_vector_type(16)));
typedef unsigned u32x2 __attribute__((ext_vector_type(2)));

#ifndef ENMASK
#define ENMASK 0xffff
#endif
#define EN(k) ((ENMASK >> (k)) & 1)
constexpr int T_ = 32768, S_ = 2048;
constexpr float EPSV = 1e-6f;
constexpr float LOG2E = 1.4426950408889634f;
constexpr size_t MiB = (size_t)1 << 20;
constexpr size_t WS_COSA = 0, WS_SINA = 128 * 1024, WS_COSB = 256 * 1024, WS_SINB = 512 * 1024;
constexpr size_t WS_SSQ = 1 * MiB;
constexpr size_t WS_W = 2 * MiB;
constexpr size_t W_IN = WS_W, W_UP = WS_W + 8 * MiB, W_EOUT = WS_W + 11 * MiB, W_QKV = WS_W + 15 * MiB, W_OOUT = WS_W + 27 * MiB, W_GU = WS_W + 31 * MiB, W_DN = WS_W + 75 * MiB;
constexpr size_t SZ_IN = 4 * MiB, SZ_UP = 3 * MiB / 2, SZ_EOUT = 2 * MiB, SZ_QKV = 6 * MiB, SZ_OOUT = 2 * MiB, SZ_GU = 11 * MiB, SZ_DN = 11 * MiB / 2;
constexpr size_t WS_XN = 100 * MiB, WS_O = 164 * MiB, WS_R = 228 * MiB;
constexpr size_t R_QB = WS_R, R_KB = WS_R + 32 * MiB, R_VBT = WS_R + 64 * MiB, R_A2 = WS_R + 96 * MiB, R_KPE = WS_R + 120 * MiB, R_QA = WS_R + 122 * MiB, R_KA = WS_R + 170 * MiB, R_VAT = WS_R + 202 * MiB;
constexpr size_t R_QC = WS_R, R_KC = WS_R + 64 * MiB, R_VCT = WS_R + 128 * MiB;
constexpr size_t R_HFF = WS_R;
constexpr size_t WS_END = WS_R + 234 * MiB;

struct Params {
    const float* in[17];
    float* out;
    unsigned char* ws;
};

__device__ __forceinline__ unsigned cvt_pk_bf16(float lo, float hi) { unsigned r; asm("v_cvt_pk_bf16_f32 %0, %1, %2" : "=v"(r) : "v"(lo), "v"(hi)); return r; }
__device__ __forceinline__ bf16_t f2bf(float f) { return (bf16_t)(cvt_pk_bf16(f, 0.f) & 0xffffu); }
__device__ __forceinline__ float fexp2(float x) { return __builtin_amdgcn_exp2f(x); }
__device__ __forceinline__ u32x2 pk4(f32x4 v) { u32x2 o; o.x = cvt_pk_bf16(v[0], v[1]); o.y = cvt_pk_bf16(v[2], v[3]); return o; }
__device__ __forceinline__ u32x4 pk8(f32x4 a, f32x4 b) { u32x4 o; o.x = cvt_pk_bf16(a[0], a[1]); o.y = cvt_pk_bf16(a[2], a[3]); o.z = cvt_pk_bf16(b[0], b[1]); o.w = cvt_pk_bf16(b[2], b[3]); return o; }

struct EpiResid {
    static constexpr bool PERM = false, AFTER_DRAIN = false;
    const float* hin; float* hout;
    __device__ __forceinline__ void operator()(const f32x4 (&acc)[2][2][4][2], const Unit& u, int wr, int wc, int fr, int fq) const {
        asm volatile("" : "+v"(fr), "+v"(fq));
        const int row0 = u.pm * 256 + wr * 64 + fr, col0 = u.pn * 256 + wc * 32 + 4 * fq;
#pragma unroll
        for (int ai = 0; ai < 2; ++ai)
#pragma unroll
            for (int m = 0; m < 4; ++m) { const size_t off = (size_t)(row0 + ai * 128 + m * 16) * 1024 + col0;
#pragma unroll
                for (int bj = 0; bj < 2; ++bj)
#pragma unroll
                    for (int n = 0; n < 2; ++n) { const f32x4 v = *(const f32x4*)(hin + off + bj * 128 + n * 16); *(f32x4*)(hout + off + bj * 128 + n * 16) = v + acc[ai][bj][m][n]; } }
    }
};
struct EpiGateUp {
    static constexpr bool PERM = false, AFTER_DRAIN = false;
    bf16_t* hff;
    __device__ __forceinline__ void operator()(const f32x4 (&acc)[2][2][4][2], const Unit& u, int wr, int wc, int fr, int fq) const {
        asm volatile("" : "+v"(fr), "+v"(fq));
        const int row0 = u.pm * 256 + wr * 64 + fr, fcol = u.pn * 128 + wc * 32 + 8 * fq;
#pragma unroll
        for (int ai = 0; ai < 2; ++ai)
#pragma unroll
            for (int m = 0; m < 4; ++m) {
                f32x4 r0, r1;
#pragma unroll
                for (int j = 0; j < 4; ++j) {
                    const float g0 = acc[ai][0][m][0][j], g1 = acc[ai][0][m][1][j];
                    r0[j] = g0 * __builtin_amdgcn_rcpf(1.f + fexp2(-g0 * LOG2E)) * acc[ai][1][m][0][j];
                    r1[j] = g1 * __builtin_amdgcn_rcpf(1.f + fexp2(-g1 * LOG2E)) * acc[ai][1][m][1][j];
                }
                *(u32x4*)(hff + (size_t)(row0 + ai * 128 + m * 16) * 2816 + fcol) = pk8(r0, r1);
            }
    }
};
struct EpiEvenIn {
    static constexpr bool PERM = false, AFTER_DRAIN = false;
    unsigned char* ws;
    __device__ __forceinline__ void operator()(const f32x4 (&acc)[2][2][4][2], const Unit& u, int wr, int wc, int fr, int fq) const {
        asm volatile("" : "+v"(fr), "+v"(fq));
        bf16_t* const qb = (bf16_t*)(ws + R_QB); bf16_t* const kb = (bf16_t*)(ws + R_KB); bf16_t* const vbt = (bf16_t*)(ws + R_VBT); bf16_t* const a2 = (bf16_t*)(ws + R_A2); bf16_t* const kpe = (bf16_t*)(ws + R_KPE);
        float* const ssq = (float*)(ws + WS_SSQ); const float* const cosA = (const float*)(ws + WS_COSA); const float* const sinA = (const float*)(ws + WS_SINA); const float* const cosB = (const float*)(ws + WS_COSB); const float* const sinB = (const float*)(ws + WS_SINB);
        const int row0 = u.pm * 256 + wr * 64 + fr, pn = u.pn;
        if (pn < 4) {
            bf16_t* dst = pn < 2 ? qb : kb; const float sc = pn < 2 ? 0.125f * LOG2E : 1.f;
#pragma unroll
            for (int ai = 0; ai < 2; ++ai)
#pragma unroll
                for (int m = 0; m < 4; ++m) { const int row = row0 + ai * 128 + m * 16, pos = row & 2047;
#pragma unroll
                    for (int bj = 0; bj < 2; ++bj) { const int g8 = 4 * bj + wc, head = 4 * (pn & 1) + (g8 >> 1), d0 = 16 * (g8 & 1) + 4 * fq;
                        const f32x4 c = *(const f32x4*)(cosB + pos * 32 + d0), s = *(const f32x4*)(sinB + pos * 32 + d0);
                        const f32x4 x1 = acc[ai][bj][m][0], x2 = acc[ai][bj][m][1];
                        const f32x4 o1 = (x1 * c - x2 * s) * sc, o2 = (x2 * c + x1 * s) * sc;
                        bf16_t* p = dst + (size_t)row * 512 + head * 64 + d0;
                        *(u32x2*)p = pk4(o1); *(u32x2*)(p + 32) = pk4(o2); } }
        } else if (pn < 6) {
#pragma unroll
            for (int ai = 0; ai < 2; ++ai)
#pragma unroll
                for (int m = 0; m < 4; ++m) { const int row = row0 + ai * 128 + m * 16, pos = row & 2047, b = row >> 11;
#pragma unroll
                    for (int bj = 0; bj < 2; ++bj)
#pragma unroll
                        for (int n = 0; n < 2; ++n) { const int f0 = (pn - 4) * 256 + bj * 128 + wc * 32 + 16 * n + 4 * fq;
                            bf16_t* p = vbt + ((size_t)(b * 8 + (f0 >> 6)) * 64 + (f0 & 63)) * 2048 + pos;
#pragma unroll
                            for (int j = 0; j < 4; ++j) p[j * 2048] = f2bf(acc[ai][bj][m][n][j]); } }
        } else if (pn == 6) {
#pragma unroll
            for (int ai = 0; ai < 2; ++ai)
#pragma unroll
                for (int m = 0; m < 4; ++m) { const int row = row0 + ai * 128 + m * 16; float ss = 0.f;
#pragma unroll
                    for (int bj = 0; bj < 2; ++bj) { const f32x4 v0 = acc[ai][bj][m][0], v1 = acc[ai][bj][m][1];
#pragma unroll
                        for (int j = 0; j < 4; ++j) ss += v0[j] * v0[j] + v1[j] * v1[j];
                        *(u32x4*)(a2 + (size_t)row * 384 + bj * 128 + wc * 32 + 8 * fq) = pk8(v0, v1); }
                    ss += __shfl_xor(ss, 16); ss += __shfl_xor(ss, 32);
                    if (fq == 0) ssq[row * 8 + wc] = ss; }
        } else {
#pragma unroll
            for (int ai = 0; ai < 2; ++ai)
#pragma unroll
                for (int m = 0; m < 4; ++m) { const int row = row0 + ai * 128 + m * 16, pos = row & 2047; float ss = 0.f;
                    { const f32x4 v0 = acc[ai][0][m][0], v1 = acc[ai][0][m][1];
#pragma unroll
                      for (int j = 0; j < 4; ++j) ss += v0[j] * v0[j] + v1[j] * v1[j];
                      *(u32x4*)(a2 + (size_t)row * 384 + 256 + wc * 32 + 8 * fq) = pk8(v0, v1); }
                    ss += __shfl_xor(ss, 16); ss += __shfl_xor(ss, 32);
                    if (fq == 0) ssq[row * 8 + 4 + wc] = ss;
                    if (wc == 0) { const int d0 = 4 * fq;
                        const f32x4 c = *(const f32x4*)(cosA + pos * 16 + d0), s = *(const f32x4*)(sinA + pos * 16 + d0);
                        const f32x4 x1 = acc[ai][1][m][0], x2 = acc[ai][1][m][1];
                        bf16_t* p = kpe + (size_t)row * 32 + d0;
                        *(u32x2*)p = pk4(x1 * c - x2 * s); *(u32x2*)(p + 16) = pk4(x2 * c + x1 * s); } }
        }
    }
};
struct EpiEvenUp {
    static constexpr bool PERM = false, AFTER_DRAIN = false;
    unsigned char* ws;
    __device__ __forceinline__ void operator()(const f32x4 (&acc)[2][2][4][2], const Unit& u, int wr, int wc, int fr, int fq) const {
        asm volatile("" : "+v"(fr), "+v"(fq));
        bf16_t* const qa = (bf16_t*)(ws + R_QA); bf16_t* const ka = (bf16_t*)(ws + R_KA); bf16_t* const vat = (bf16_t*)(ws + R_VAT);
        const float* const ssq = (const float*)(ws + WS_SSQ); const float* const cosA = (const float*)(ws + WS_COSA); const float* const sinA = (const float*)(ws + WS_SINA);
        const int row0 = u.pm * 256 + wr * 64 + fr, pn = u.pn;
        if (pn < 3) {
            int hoff[2], part[2];
#pragma unroll
            for (int bj = 0; bj < 2; ++bj) { const int G = 8 * pn + 4 * bj + wc, head = G / 3; part[bj] = G - 3 * head; hoff[bj] = head * 96 + (part[bj] < 2 ? 32 * part[bj] + 8 * fq : 64 + 4 * fq); }
#pragma unroll
            for (int ai = 0; ai < 2; ++ai)
#pragma unroll
                for (int m = 0; m < 4; ++m) { const int row = row0 + ai * 128 + m * 16, pos = row & 2047;
                    const f32x4 q = *(const f32x4*)(ssq + row * 8);
                    const float rs = rsqrtf((q[0] + q[1] + q[2] + q[3]) * (1.f / 256.f) + EPSV) * (0.10206207261596575f * LOG2E);
#pragma unroll
                    for (int bj = 0; bj < 2; ++bj) {
                        const f32x4 x1 = acc[ai][bj][m][0] * rs, x2 = acc[ai][bj][m][1] * rs;
                        bf16_t* p = qa + (size_t)row * 768 + hoff[bj];
                        if (part[bj] < 2) *(u32x4*)p = pk8(x1, x2);
                        else { const f32x4 c = *(const f32x4*)(cosA + pos * 16 + 4 * fq), s = *(const f32x4*)(sinA + pos * 16 + 4 * fq);
                            *(u32x2*)p = pk4(x1 * c - x2 * s); *(u32x2*)(p + 16) = pk4(x2 * c + x1 * s); } }
                    __builtin_amdgcn_sched_barrier(0); }
        } else {
            int head[2], part[2];
#pragma unroll
            for (int bj = 0; bj < 2; ++bj) { const int G = 8 * (pn - 3) + 4 * bj + wc; head[bj] = G >> 2; part[bj] = G & 3; }
#pragma unroll
            for (int ai = 0; ai < 2; ++ai)
#pragma unroll
                for (int m = 0; m < 4; ++m) { const int row = row0 + ai * 128 + m * 16, pos = row & 2047, b = row >> 11;
                    const f32x4 q = *(const f32x4*)(ssq + row * 8 + 4);
                    const float rs = rsqrtf((q[0] + q[1] + q[2] + q[3]) * (1.f / 128.f) + EPSV);
#pragma unroll
                    for (int bj = 0; bj < 2; ++bj) {
                        const f32x4 x1 = acc[ai][bj][m][0] * rs, x2 = acc[ai][bj][m][1] * rs;
                        if (part[bj] < 2) *(u32x4*)(ka + (size_t)row * 512 + head[bj] * 64 + 32 * part[bj] + 8 * fq) = pk8(x1, x2);
                        else { bf16_t* p = vat + ((size_t)(b * 8 + head[bj]) * 64 + 32 * (part[bj] - 2) + 4 * fq) * 2048 + pos;
#pragma unroll
                            for (int j = 0; j < 4; ++j) { p[j * 2048] = f2bf(x1[j]); p[(16 + j) * 2048] = f2bf(x2[j]); } } }
                    __builtin_amdgcn_sched_barrier(0); }
        }
    }
};
struct EpiOddQKV {
    static constexpr bool PERM = false, AFTER_DRAIN = false;
    unsigned char* ws;
    __device__ __forceinline__ void operator()(const f32x4 (&acc)[2][2][4][2], const Unit& u, int wr, int wc, int fr, int fq) const {
        asm volatile("" : "+v"(fr), "+v"(fq));
        bf16_t* const qc = (bf16_t*)(ws + R_QC); bf16_t* const kc = (bf16_t*)(ws + R_KC); bf16_t* const vct = (bf16_t*)(ws + R_VCT);
        const int row0 = u.pm * 256 + wr * 64 + fr, pn = u.pn;
        if (pn < 8) {
            bf16_t* dst = pn < 4 ? qc : kc; const float sc = pn < 4 ? 0.125f * LOG2E : 1.f;
#pragma unroll
            for (int ai = 0; ai < 2; ++ai)
#pragma unroll
                for (int m = 0; m < 4; ++m) { const int row = row0 + ai * 128 + m * 16;
#pragma unroll
                    for (int bj = 0; bj < 2; ++bj)
                        *(u32x4*)(dst + (size_t)row * 1024 + (pn & 3) * 256 + bj * 128 + wc * 32 + 8 * fq) = pk8(acc[ai][bj][m][0] * sc, acc[ai][bj][m][1] * sc); }
        } else {
#pragma unroll
            for (int ai = 0; ai < 2; ++ai)
#pragma unroll
                for (int m = 0; m < 4; ++m) { const int row = row0 + ai * 128 + m * 16, pos = row & 2047, b = row >> 11;
#pragma unroll
                    for (int bj = 0; bj < 2; ++bj)
#pragma unroll
                        for (int n = 0; n < 2; ++n) { const int f0 = (pn - 8) * 256 + bj * 128 + wc * 32 + 16 * n + 4 * fq;
                            bf16_t* p = vct + ((size_t)(b * 16 + (f0 >> 6)) * 64 + (f0 & 63)) * 2048 + pos;
#pragma unroll
                            for (int j = 0; j < 4; ++j) p[j * 2048] = f2bf(acc[ai][bj][m][n][j]); } }
        }
    }
};

enum { MAP_IDENT = 0, MAP_EVIN, MAP_QUP, MAP_KVUP, MAP_ODQKV, MAP_GU };
__device__ __forceinline__ int p32(int w) { return (w & ~31) + pg8::perm32(w & 31); }
__device__ __forceinline__ int src_col(int map, int c, int sel) {
    switch (map) {
    case MAP_EVIN: { const int pn = c >> 8, w = c & 255;
        if (pn < 4) { const int g8 = w >> 5, rho = w & 31, d = 16 * (g8 & 1) + (rho & 15) + 32 * (rho >> 4), head = 4 * (pn & 1) + (g8 >> 1); return 416 + (pn >> 1) * 512 + head * 64 + d; }
        if (pn < 6) return 416 + 1024 + (pn - 4) * 256 + w;
        if (pn == 6) return p32(w);
        if (w < 128) return 256 + p32(w);
        if (w < 160) return 384 + (w - 128);
        return -1; }
    case MAP_QUP: { const int G = c >> 5, head = G / 3, part = G - 3 * head, rho = c & 31; return part < 2 ? head * 96 + 32 * part + pg8::perm32(rho) : head * 96 + 64 + rho; }
    case MAP_KVUP: { const int G = c >> 5, head = G >> 2, part = G & 3, rho = c & 31; return part < 2 ? head * 128 + 32 * part + pg8::perm32(rho) : head * 128 + 32 * part + rho; }
    case MAP_ODQKV: { const int which = c >> 10, f = c & 1023; return which < 2 ? which * 1024 + p32(f) : 2048 + f; }
    case MAP_GU: { const int pn = c >> 8, bj = (c >> 7) & 1, w = c & 127; if (bj != sel) return -2; return 128 * pn + p32(w); }
    default: return c;
    }
}
__device__ __forceinline__ void prep_w(float* tl, const float* __restrict__ W, int Nsrc, int Ksrc, const float* __restrict__ gain, bf16_t* Bt, int Kt, int klo, int row0, int nrows, int map, int sel) {
    const int tid = threadIdx.x, nkt = Kt >> 6, ntile = (nrows >> 6) * nkt;
    for (int t = blockIdx.x; t < ntile; t += gridDim.x) {
        const int tr = t / nkt, tk = t - tr * nkt;
        if (map == MAP_GU && src_col(map, tr * 64, sel) == -2) continue;
        { const int c = tid & 63, kq = tid >> 6, src = src_col(map, tr * 64 + c, sel);
#pragma unroll
          for (int i = 0; i < 8; ++i) { const int ks = tk * 64 + kq * 8 + i - klo; float v = 0.f;
              if (src >= 0 && ks >= 0 && ks < Ksrc) { v = W[(size_t)ks * Nsrc + src]; if (gain) v *= gain[ks]; }
              tl[(kq * 8 + i) * 65 + c] = v; } }
        __syncthreads();
        { const int kc = tid & 7, c = tid >> 3; float v[8];
#pragma unroll
          for (int i = 0; i < 8; ++i) v[i] = tl[(kc * 8 + i) * 65 + c];
          u32x4 o; o.x = cvt_pk_bf16(v[0], v[1]); o.y = cvt_pk_bf16(v[2], v[3]); o.z = cvt_pk_bf16(v[4], v[5]); o.w = cvt_pk_bf16(v[6], v[7]);
          *(u32x4*)(Bt + (size_t)(row0 + tr * 64 + c) * Kt + tk * 64 + kc * 8) = o; }
        __syncthreads();
    }
}

__device__ __forceinline__ void norm_phase(const float* __restrict__ h, bf16_t* xn, float* outf, const float* __restrict__ g, int gw, int nw, int lane) {
    for (int row = gw; row < T_; row += nw) {
        const f32x4* p = (const f32x4*)(h + (size_t)row * 1024);
        f32x4 v[4]; float ss = 0.f;
#pragma unroll
        for (int i = 0; i < 4; ++i) { v[i] = p[lane + 64 * i]; ss += v[i][0] * v[i][0] + v[i][1] * v[i][1] + v[i][2] * v[i][2] + v[i][3] * v[i][3]; }
#pragma unroll
        for (int o = 32; o >= 1; o >>= 1) ss += __shfl_xor(ss, o);
        const float rs = rsqrtf(ss * (1.f / 1024.f) + EPSV);
        if (outf) {
#pragma unroll
            for (int i = 0; i < 4; ++i) { const f32x4 gg = *(const f32x4*)(g + 4 * (lane + 64 * i)); *(f32x4*)(outf + (size_t)row * 1024 + 4 * (lane + 64 * i)) = v[i] * rs * gg; }
        } else {
#pragma unroll
            for (int i = 0; i < 4; ++i) *(u32x2*)(xn + (size_t)row * 1024 + 4 * (lane + 64 * i)) = pk4(v[i] * rs);
        }
    }
}

#define MFMA32(a, b, c) __builtin_amdgcn_mfma_f32_32x32x16_bf16(a, b, c, 0, 0, 0)
__device__ __forceinline__ bf16x8 mk8(u32x2 a, u32x2 b) { u32x4 t; t.x = a.x; t.y = a.y; t.z = b.x; t.w = b.y; return __builtin_bit_cast(bf16x8, t); }
__device__ __forceinline__ void softmax_pv(const f32x16& s, f32x16& o0, f32x16& o1, float& m, float& l, const bf16x8 v00, const bf16x8 v01, const bf16x8 v10, const bf16x8 v11) {
    float mx = s[0];
#pragma unroll
    for (int i = 1; i < 16; ++i) mx = fmaxf(mx, s[i]);
    mx = fmaxf(mx, __shfl_xor(mx, 32));
    const float mn = fmaxf(m, mx);
    const float alpha = fexp2(m - mn);
    f32x16 p; float sum = 0.f;
#pragma unroll
    for (int i = 0; i < 16; ++i) { p[i] = fexp2(s[i] - mn); sum += p[i]; }
    l = l * alpha + sum; m = mn;
    o0 *= alpha; o1 *= alpha;
    u32x4 a, b;
    a.x = cvt_pk_bf16(p[0], p[1]); a.y = cvt_pk_bf16(p[2], p[3]); a.z = cvt_pk_bf16(p[4], p[5]); a.w = cvt_pk_bf16(p[6], p[7]);
    b.x = cvt_pk_bf16(p[8], p[9]); b.y = cvt_pk_bf16(p[10], p[11]); b.z = cvt_pk_bf16(p[12], p[13]); b.w = cvt_pk_bf16(p[14], p[15]);
    const bf16x8 pk0 = __builtin_bit_cast(bf16x8, a), pk1 = __builtin_bit_cast(bf16x8, b);
    o0 = MFMA32(v00, pk0, o0); o0 = MFMA32(v01, pk1, o0);
    o1 = MFMA32(v10, pk0, o1); o1 = MFMA32(v11, pk1, o1);
}
__device__ __forceinline__ void attn_store(const f32x16& o0, const f32x16& o1, float l, bf16_t* op  ) {
    const float inv = 1.f / (l + __shfl_xor(l, 32));
#pragma unroll
    for (int g = 0; g < 4; ++g) {
        u32x2 a, b;
        a.x = cvt_pk_bf16(o0[4 * g] * inv, o0[4 * g + 1] * inv); a.y = cvt_pk_bf16(o0[4 * g + 2] * inv, o0[4 * g + 3] * inv);
        b.x = cvt_pk_bf16(o1[4 * g] * inv, o1[4 * g + 1] * inv); b.y = cvt_pk_bf16(o1[4 * g + 2] * inv, o1[4 * g + 3] * inv);
        *(u32x2*)(op + 8 * g) = a; *(u32x2*)(op + 32 + 8 * g) = b;
    }
}
__device__ __forceinline__ void load_vt(const bf16_t* vrow, bf16x8& v00, bf16x8& v01, bf16x8& v10, bf16x8& v11) {
    v00 = mk8(*(const u32x2*)(vrow), *(const u32x2*)(vrow + 8)); v01 = mk8(*(const u32x2*)(vrow + 16), *(const u32x2*)(vrow + 24));
    const bf16_t* v1 = vrow + 32 * 2048;
    v10 = mk8(*(const u32x2*)(v1), *(const u32x2*)(v1 + 8)); v11 = mk8(*(const u32x2*)(v1 + 16), *(const u32x2*)(v1 + 24));
}

__device__ __forceinline__ void mla_item(int item, const bf16_t* __restrict__ QA, const bf16_t* __restrict__ KA, const bf16_t* __restrict__ KPE, const bf16_t* __restrict__ VAT, bf16_t* O, int lane) {
    const int qblk = item & 63, head = (item >> 6) & 7, b = item >> 9, r = lane & 31, h = lane >> 5;
    const size_t tq = (size_t)b * 2048 + qblk * 32 + r;
    bf16x8 qf[6];
#pragma unroll
    for (int kk = 0; kk < 6; ++kk) qf[kk] = *(const bf16x8*)(QA + tq * 768 + head * 96 + 16 * kk + 8 * h);
    const bf16_t* kbase = KA + ((size_t)b * 2048 + r) * 512 + head * 64 + 8 * h;
    const bf16_t* pbase = KPE + ((size_t)b * 2048 + r) * 32 + 8 * h;
    const bf16_t* vbase = VAT + ((size_t)(b * 8 + head) * 64 + r) * 2048 + 4 * h;
    f32x16 o0, o1;
#pragma unroll
    for (int i = 0; i < 16; ++i) { o0[i] = 0.f; o1[i] = 0.f; }
    float m = -1e30f, l = 0.f;
    bf16x8 kf[6], v00, v01, v10, v11;
#pragma unroll
    for (int kk = 0; kk < 4; ++kk) kf[kk] = *(const bf16x8*)(kbase + 16 * kk);
    kf[4] = *(const bf16x8*)(pbase); kf[5] = *(const bf16x8*)(pbase + 16);
    load_vt(vbase, v00, v01, v10, v11);
    for (int kt = 0; kt < 64; ++kt) {
        const int pn = (kt < 63 ? kt + 1 : 63) * 32;
        bf16x8 kn[6], n00, n01, n10, n11;
#pragma unroll
        for (int kk = 0; kk < 4; ++kk) kn[kk] = *(const bf16x8*)(kbase + (size_t)pn * 512 + 16 * kk);
        kn[4] = *(const bf16x8*)(pbase + pn * 32); kn[5] = *(const bf16x8*)(pbase + pn * 32 + 16);
        load_vt(vbase + pn, n00, n01, n10, n11);
        f32x16 s;
#pragma unroll
        for (int i = 0; i < 16; ++i) s[i] = 0.f;
#pragma unroll
        for (int kk = 0; kk < 6; ++kk) s = MFMA32(kf[kk], qf[kk], s);
        softmax_pv(s, o0, o1, m, l, v00, v01, v10, v11);
#pragma unroll
        for (int kk = 0; kk < 6; ++kk) kf[kk] = kn[kk];
        v00 = n00; v01 = n01; v10 = n10; v11 = n11;
    }
    attn_store(o0, o1, l, O + tq * 1024 + head * 64 + 4 * h);
}

template <int D>
__device__ __forceinline__ void dil_tile(int u0, int rho, int qsub, const bf16_t* __restrict__ kb, const bf16_t* __restrict__ vb, const bf16x8 (&qf)[4], f32x16& o0, f32x16& o1, float& m, float& l, int r, int h) {
    const int kpos = D * (u0 + r) + rho;
    bf16x8 kf[4];
#pragma unroll
    for (int kk = 0; kk < 4; ++kk) kf[kk] = *(const bf16x8*)(kb + (size_t)kpos * 512 + 16 * kk);
    bf16x8 v00, v01, v10, v11;
    if (D == 1) load_vt(vb + u0 + 4 * h, v00, v01, v10, v11);
    else {
        bf16x8 vv[2][2];
#pragma unroll
        for (int dt = 0; dt < 2; ++dt)
#pragma unroll
            for (int s = 0; s < 2; ++s) {
                unsigned w[4];
#pragma unroll
                for (int e2 = 0; e2 < 4; ++e2) {
                    const int slot = u0 + 16 * s + 8 * (e2 >> 1) + 4 * h + 2 * (e2 & 1);
                    const unsigned lo = vb[(size_t)dt * 65536 + D * slot + rho], hi = vb[(size_t)dt * 65536 + D * (slot + 1) + rho];
                    w[e2] = lo | (hi << 16);
                }
                u32x4 t; t.x = w[0]; t.y = w[1]; t.z = w[2]; t.w = w[3]; vv[dt][s] = __builtin_bit_cast(bf16x8, t);
            }
        v00 = vv[0][0]; v01 = vv[0][1]; v10 = vv[1][0]; v11 = vv[1][1];
    }
    f32x16 s;
#pragma unroll
    for (int i = 0; i < 16; ++i) s[i] = 0.f;
#pragma unroll
    for (int kk = 0; kk < 4; ++kk) s = MFMA32(kf[kk], qf[kk], s);
#pragma unroll
    for (int i = 0; i < 16; ++i) { const int dd = u0 + 8 * (i >> 2) + 4 * h + (i & 3) - qsub; s[i] = (dd <= 64 && dd >= -64) ? s[i] : -__builtin_inff(); }
    softmax_pv(s, o0, o1, m, l, v00, v01, v10, v11);
}
__device__ __forceinline__ void dil_item(int item, const bf16_t* __restrict__ QB, const bf16_t* __restrict__ KB, const bf16_t* __restrict__ VBT, bf16_t* O, int lane) {
    const int rr = item & 15, a = (item >> 4) & 3, head = (item >> 6) & 7, b = item >> 9, r = lane & 31, h = lane >> 5;
    const int tq = 512 * a + rr + 16 * r;
    bf16x8 qf[4];
#pragma unroll
    for (int kk = 0; kk < 4; ++kk) qf[kk] = *(const bf16x8*)(QB + ((size_t)b * 2048 + tq) * 512 + head * 64 + 16 * kk + 8 * h);
    const bf16_t* kb = KB + (size_t)b * 2048 * 512 + head * 64 + 8 * h;
    const bf16_t* vb = VBT + ((size_t)(b * 8 + head) * 64 + r) * 2048;
    f32x16 o0, o1;
#pragma unroll
    for (int i = 0; i < 16; ++i) { o0[i] = 0.f; o1[i] = 0.f; }
    float m = -1e30f, l = 0.f;
    for (int k = 0; k < 20; ++k) { const int u0 = 512 * a - 64 + 32 * k; if (u0 < 0 || u0 >= 2048) continue; dil_tile<1>(u0, 0, tq, kb, vb, qf, o0, o1, m, l, r, h); }
    for (int k = 0; k < 8; ++k) { const int u0 = 128 * a - 64 + 32 * k; if (u0 < 0 || u0 >= 512) continue; dil_tile<4>(u0, rr & 3, 128 * a + (rr >> 2) + 4 * r, kb, vb, qf, o0, o1, m, l, r, h); }
    for (int k = 0; k < 5; ++k) { const int u0 = 32 * a - 64 + 32 * k; if (u0 < 0 || u0 >= 128) continue; dil_tile<16>(u0, rr, 32 * a + r, kb, vb, qf, o0, o1, m, l, r, h); }
    attn_store(o0, o1, l, O + ((size_t)b * 2048 + tq) * 1024 + 512 + head * 64 + 4 * h);
}

__device__ __forceinline__ int clampi(int v, int lo, int hi) { return v < lo ? lo : (v > hi ? hi : v); }
__device__ __forceinline__ void na_item(int item, const bf16_t* __restrict__ QC, const bf16_t* __restrict__ KC, const bf16_t* __restrict__ VCT, const float* __restrict__ rpb, bf16_t* O, int lane) {
    const int j = item & 3, rp = (item >> 2) & 15, head = (item >> 6) & 15, b = item >> 10, r = lane & 31, h = lane >> 5;
    const int qrow = 2 * rp + (r >> 4), qcol = 16 * j + (r & 15), tq = qrow * 64 + qcol;
    bf16x8 qf[4];
#pragma unroll
    for (int kk = 0; kk < 4; ++kk) qf[kk] = *(const bf16x8*)(QC + ((size_t)b * 2048 + tq) * 1024 + head * 64 + 16 * kk + 8 * h);
    const int rs_q = clampi(qrow - 4, 0, 24), cs_q = clampi(qcol - 8, 0, 48), band = clampi(16 * j - 8, 0, 32);
    const int kr_lo = clampi(2 * rp - 4, 0, 24), kr_hi = clampi(2 * rp - 3, 0, 24) + 8;
    const bf16_t* kb = KC + ((size_t)b * 2048 + band + r) * 1024 + head * 64 + 8 * h;
    const bf16_t* vb = VCT + ((size_t)(b * 16 + head) * 64 + r) * 2048 + band + 4 * h;
    const float* rp_h = rpb + head * 465;
    f32x16 o0, o1;
#pragma unroll
    for (int i = 0; i < 16; ++i) { o0[i] = 0.f; o1[i] = 0.f; }
    float m = -1e30f, l = 0.f;
    for (int kr = kr_lo; kr < kr_hi; ++kr) {
        bf16x8 kf[4], v00, v01, v10, v11;
#pragma unroll
        for (int kk = 0; kk < 4; ++kk) kf[kk] = *(const bf16x8*)(kb + (size_t)kr * 65536 + 16 * kk);
        load_vt(vb + kr * 64, v00, v01, v10, v11);
        f32x16 s;
#pragma unroll
        for (int i = 0; i < 16; ++i) s[i] = 0.f;
#pragma unroll
        for (int kk = 0; kk < 4; ++kk) s = MFMA32(kf[kk], qf[kk], s);
        const bool rowok = (kr >= rs_q) && (kr < rs_q + 8);
        const int ro = clampi(kr - qrow + 7, 0, 14);
#pragma unroll
        for (int i = 0; i < 16; ++i) { const int kc = band + 8 * (i >> 2) + 4 * h + (i & 3); const bool ok = rowok && (kc >= cs_q) && (kc < cs_q + 16);
            const float bias = ok ? rp_h[ro * 31 + (kc - qcol + 15)] : 0.f;
            s[i] = ok ? s[i] + bias * LOG2E : -__builtin_inff(); }
        softmax_pv(s, o0, o1, m, l, v00, v01, v10, v11);
    }
    attn_store(o0, o1, l, O + ((size_t)b * 2048 + tq) * 1024 + head * 64 + 4 * h);
}

__device__ __forceinline__ int my_tid(int wid_s) { int t = wid_s * 64 + (int)__builtin_amdgcn_mbcnt_hi(~0u, __builtin_amdgcn_mbcnt_lo(~0u, 0u)); asm volatile("" : "+v"(t)); return t; }
__global__ void __launch_bounds__(512, 2) fwd_kernel(Params p) {
    extern __shared__ __attribute__((aligned(16))) unsigned char shm[];
    cg::grid_group grid = cg::this_grid();
    PG8_LAS unsigned char* lds = (PG8_LAS unsigned char*)shm;
    const int tid = threadIdx.x, lane = tid & 63, wid = tid >> 6;
    const int wid_s = __builtin_amdgcn_readfirstlane(wid);
    const int gw = blockIdx.x * 8 + wid, nw = gridDim.x * 8;
    float* H = p.out;

    if (EN(10))
    {
        unsigned char* ws = p.ws; float* cosA = (float*)(ws + WS_COSA); float* sinA = (float*)(ws + WS_SINA); float* cosB = (float*)(ws + WS_COSB); float* sinB = (float*)(ws + WS_SINB); bf16_t* XN = (bf16_t*)(ws + WS_XN);
        float* tl = (float*)shm;
        for (int i = 0; i < 2; ++i) {
            prep_w(tl, p.in[2] + (size_t)i * 1024 * 1952, 1952, 1024, p.in[1] + i * 1024, (bf16_t*)(ws + W_IN + i * SZ_IN), 1024, 0, 0, 2048, MAP_EVIN, 0);
            prep_w(tl, p.in[4] + (size_t)i * 256 * 768, 768, 256, p.in[3] + i * 256, (bf16_t*)(ws + W_UP + i * SZ_UP), 384, 0, 0, 768, MAP_QUP, 0);
            prep_w(tl, p.in[6] + (size_t)i * 128 * 1024, 1024, 128, p.in[5] + i * 128, (bf16_t*)(ws + W_UP + i * SZ_UP), 384, 256, 768, 1024, MAP_KVUP, 0);
            prep_w(tl, p.in[7] + (size_t)i * 1024 * 1024, 1024, 1024, nullptr, (bf16_t*)(ws + W_EOUT + i * SZ_EOUT), 1024, 0, 0, 1024, MAP_IDENT, 0);
            prep_w(tl, p.in[9] + (size_t)i * 1024 * 3072, 3072, 1024, p.in[8] + i * 1024, (bf16_t*)(ws + W_QKV + i * SZ_QKV), 1024, 0, 0, 3072, MAP_ODQKV, 0);
            prep_w(tl, p.in[11] + (size_t)i * 1024 * 1024, 1024, 1024, nullptr, (bf16_t*)(ws + W_OOUT + i * SZ_OOUT), 1024, 0, 0, 1024, MAP_IDENT, 0);
        }
        for (int L = 0; L < 4; ++L) {
            prep_w(tl, p.in[13] + (size_t)L * 1024 * 2816, 2816, 1024, p.in[12] + L * 1024, (bf16_t*)(ws + W_GU + L * SZ_GU), 1024, 0, 0, 5632, MAP_GU, 0);
            prep_w(tl, p.in[14] + (size_t)L * 1024 * 2816, 2816, 1024, p.in[12] + L * 1024, (bf16_t*)(ws + W_GU + L * SZ_GU), 1024, 0, 0, 5632, MAP_GU, 1);
            prep_w(tl, p.in[15] + (size_t)L * 2816 * 1024, 1024, 2816, nullptr, (bf16_t*)(ws + W_DN + L * SZ_DN), 2816, 0, 0, 1024, MAP_IDENT, 0);
        }
        for (int idx = blockIdx.x * 512 + tid; idx < 2048 * 32; idx += gridDim.x * 512) {
            const int pos = idx >> 5, i = idx & 31; const float inv = powf(10000.f, -(float)(2 * i) / 64.f), ang = (float)pos * inv;
            cosB[idx] = cosf(ang); sinB[idx] = sinf(ang);
            if (i < 16) { const float inva = powf(10000.f, -(float)(2 * i) / 32.f), anga = (float)pos * inva; cosA[pos * 16 + i] = cosf(anga); sinA[pos * 16 + i] = sinf(anga); }
        }
        norm_phase(p.in[0], XN, nullptr, nullptr, gw, nw, lane);
    }
    grid.sync();

    for (int ph = 0; ph < 30; ++ph) {
        const int lp = ph / 15, q = ph - 15 * lp;
        unsigned char* ws = p.ws; asm volatile("" : "+s"(ws));
        bf16_t* XN = (bf16_t*)(ws + WS_XN); bf16_t* O = (bf16_t*)(ws + WS_O); bf16_t* HFF = (bf16_t*)(ws + R_HFF);
        if (EN(0) && q == 0) {
            pg8::Gemm g{XN, (const bf16_t*)(ws + W_IN + lp * SZ_IN), T_, 2048, 1024};
            pg8::StaticOrder S; S.init(g.M, g.N, (int)gridDim.x, (int)blockIdx.x);
            EpiEvenIn E{ws};
            pg8::gemm_phase<EpiEvenIn, pg8::StaticOrder, false>(lds, g, S, E, nullptr, my_tid(wid_s));
        } else if (EN(1) && q == 1) {
            pg8::Gemm g{(const bf16_t*)(ws + R_A2), (const bf16_t*)(ws + W_UP + lp * SZ_UP), T_, 1792, 384};
            pg8::StaticOrder S; S.init(g.M, g.N, (int)gridDim.x, (int)blockIdx.x);
            EpiEvenUp E{ws};
            pg8::gemm_phase<EpiEvenUp, pg8::StaticOrder, false>(lds, g, S, E, nullptr, my_tid(wid_s));
        } else if (EN(2) && q == 2) {
            const int t2 = my_tid(wid_s), lane = t2 & 63, gw = blockIdx.x * 8 + (t2 >> 6);
            for (int item = gw; item < 16384; item += nw) {
                if (item < 8192) { if (EN(8)) mla_item(item, (const bf16_t*)(ws + R_QA), (const bf16_t*)(ws + R_KA), (const bf16_t*)(ws + R_KPE), (const bf16_t*)(ws + R_VAT), O, lane); }
                else if (EN(9)) dil_item(item - 8192, (const bf16_t*)(ws + R_QB), (const bf16_t*)(ws + R_KB), (const bf16_t*)(ws + R_VBT), O, lane);
            }
        } else if (EN(3) && (q == 3 || q == 6 || q == 10 || q == 13)) {
            const bool dn = (q == 6 || q == 13);
            const bf16_t* Bt = q == 3 ? (const bf16_t*)(ws + W_EOUT + lp * SZ_EOUT) : q == 10 ? (const bf16_t*)(ws + W_OOUT + lp * SZ_OOUT) : (const bf16_t*)(ws + W_DN + (2 * lp + (q == 13)) * SZ_DN);
            pg8::Gemm g{dn ? HFF : O, Bt, T_, 1024, dn ? 2816 : 1024};
            pg8::StaticOrder S; S.init(g.M, g.N, (int)gridDim.x, (int)blockIdx.x);
            EpiResid E{ph == 3 ? p.in[0] : H, H};
            pg8::gemm_phase<EpiResid, pg8::StaticOrder, false>(lds, g, S, E, nullptr, my_tid(wid_s));
        } else if (EN(4) && (q == 4 || q == 7 || q == 11 || q == 14)) {
            const int t2 = my_tid(wid_s), lane = t2 & 63, gw = blockIdx.x * 8 + (t2 >> 6);
            if (ph == 29) norm_phase(H, nullptr, p.out, p.in[16], gw, nw, lane);
            else norm_phase(H, XN, nullptr, nullptr, gw, nw, lane);
        } else if (EN(5) && (q == 5 || q == 12)) {
            pg8::Gemm g{XN, (const bf16_t*)(ws + W_GU + (2 * lp + (q == 12)) * SZ_GU), T_, 5632, 1024};
            pg8::StaticOrder S; S.init(g.M, g.N, (int)gridDim.x, (int)blockIdx.x);
            EpiGateUp E{HFF};
            pg8::gemm_phase<EpiGateUp, pg8::StaticOrder, false>(lds, g, S, E, nullptr, my_tid(wid_s));
        } else if (EN(6) && q == 8) {
            pg8::Gemm g{XN, (const bf16_t*)(ws + W_QKV + lp * SZ_QKV), T_, 3072, 1024};
            pg8::StaticOrder S; S.init(g.M, g.N, (int)gridDim.x, (int)blockIdx.x);
            EpiOddQKV E{ws};
            pg8::gemm_phase<EpiOddQKV, pg8::StaticOrder, false>(lds, g, S, E, nullptr, my_tid(wid_s));
        } else if (EN(7) && q == 9) {
            const int t2 = my_tid(wid_s), lane = t2 & 63, gw = blockIdx.x * 8 + (t2 >> 6);
            for (int item = gw; item < 16384; item += nw)
                na_item(item, (const bf16_t*)(ws + R_QC), (const bf16_t*)(ws + R_KC), (const bf16_t*)(ws + R_VCT), p.in[10] + (size_t)lp * 16 * 465, O, lane);
        }
        if (ph != 29) grid.sync();
    }
}

extern "C" void kernel_launch(void* const* d_in, const int* in_sizes, int n_in, void* d_out, int out_size, void* d_ws, size_t ws_size, hipStream_t stream) {
    constexpr int LDS_BYTES = pg8::STAGE_BYTES;
    static int grid = 0;
    if (grid == 0) {
        if (n_in != 17 || out_size != T_ * 1024 || ws_size < WS_END) { fprintf(stderr, "kernel_launch: unexpected shapes (n_in %d out %d ws %zu, need %zu)\n", n_in, out_size, ws_size, (size_t)WS_END); grid = -1; return; }
        int dev = 0, cus = 0, per_cu = 0;
        hipGetDevice(&dev);
        hipDeviceGetAttribute(&cus, hipDeviceAttributeMultiprocessorCount, dev);
        if (hipFuncSetAttribute((const void*)fwd_kernel, hipFuncAttributeMaxDynamicSharedMemorySize, LDS_BYTES) != hipSuccess) { fprintf(stderr, "kernel_launch: hipFuncSetAttribute failed\n"); grid = -1; return; }
        if (hipOccupancyMaxActiveBlocksPerMultiprocessor(&per_cu, (const void*)fwd_kernel, 512, LDS_BYTES) != hipSuccess || per_cu < 1) { fprintf(stderr, "kernel_launch: occupancy query says %d\n", per_cu); per_cu = 1; }
        (void)hipGetLastError();
        grid = cus * 1;
    }
    if (grid < 0) return;
    Params p{};
    for (int i = 0; i < 17; ++i) p.in[i] = (const float*)d_in[i];
    p.out = (float*)d_out; p.ws = (unsigned char*)d_ws;
    void* args[] = {&p};
    hipError_t e = hipLaunchCooperativeKernel((const void*)fwd_kernel, dim3(grid), dim3(512), args, LDS_BYTES, stream);
    if (e != hipSuccess) fprintf(stderr, "cooperative launch failed: %s (grid %d)\n", hipGetErrorString(e), grid);
}
```

```cpp
#include <hip/hip_runtime.h>
#include <hip/hip_cooperative_groups.h>
#include <cstdio>
#include <cstdint>
namespace cg = cooperative_groups;
namespace pg8 {
#define PG8_LAS __attribute__((address_space(3)))
typedef unsigned short bf16_t;
typedef short bf16x8 __attribute__((ext_vector_type(8)));
typedef float f32x4 __attribute__((ext_vector_type(4)));
typedef unsigned u32x4 __attribute__((ext_vector_type(4)));
constexpr int BM = 256, BK = 64, HALF = 128, HTB = HALF * BK * 2  , STAGE_BYTES = 8 * HTB, NXCD = 8, WGM = 8;

__host__ __device__ __forceinline__ int lds_byte(int r, int c) { const int st = (r >> 4) * 2 + (c >> 5), rr = r & 15, cc = c & 31, ob = rr * 64 + cc * 2; return st * 1024 + (ob ^ (((ob >> 9) & 1) << 5)); }
__host__ __device__ __forceinline__ void stage_rc(int b, int& R, int& C) { const int st = b / 1024, sb = b % 1024, swz = sb ^ (((sb >> 9) & 1) << 5); R = (st >> 1) * 16 + swz / 64; C = (st & 1) * 32 + (swz % 64) / 2; }
__host__ __device__ __forceinline__ int perm32(int rho) { const int n = rho >> 4, i = rho & 15; return 8 * (i >> 2) + 4 * n + (i & 3); }

struct Unit { int pm, pn; };
struct Gemm { const bf16_t* A; const bf16_t* Bt; int M, N, K; };

struct StaticOrder {
    int nM, nN, nwg, G, c;
    __host__ __device__ void init(int M, int N, int G_, int c_) { nM = M / BM; nN = N / BM; nwg = nM * nN; G = G_; c = c_; }
    __host__ __device__ bool next(int i, Unit& u) const {
        const long L = (long)i * G + c; if (L >= nwg) return false;
        int wgid = (int)L; { const int q = nwg / NXCD, r = nwg % NXCD, xcd = wgid % NXCD, off = wgid / NXCD; wgid = (xcd < r ? xcd * (q + 1) : r * (q + 1) + (xcd - r) * q) + off; }
        const int nig = WGM * nN, gid = wgid / nig, fm = gid * WGM, gsz = (nM - fm) < WGM ? (nM - fm) : WGM;
        u.pm = fm + ((wgid % nig) % gsz); u.pn = (wgid % nig) / gsz; return true;
    }
    __device__ __forceinline__ void a_ready(const Unit&) const {}
    __device__ __forceinline__ void done(const Unit&) const {}
};
template <class Epi, class Sched, bool STAMP = false>
__device__ __forceinline__ void gemm_phase(PG8_LAS unsigned char* lds, const Gemm g, const Sched& S, const Epi& E, unsigned long long* stamps, int tid_in) {
    int tid_l = tid_in; asm volatile("" : "+v"(tid_l));
    const int tid = tid_l, wid = __builtin_amdgcn_readfirstlane(tid >> 6), lane = tid & 63, wr = wid >> 2, wc = wid & 3, fr = lane & 15, fq = lane >> 4;
    const int K = g.K, nt = K / BK;
    int ts_lo = 0, ts_hi = 0, nts = 0; const unsigned long long rt_entry = STAMP ? (unsigned long long)wall_clock64() : 0ull;
#define PG8_STAMP() do { if (STAMP && wid == 0 && nts < 64) { const unsigned long long _c = (unsigned long long)clock64(); \
        ts_lo = (lane == nts) ? (int)(unsigned)_c : ts_lo; ts_hi = (lane == nts) ? (int)(unsigned)(_c >> 32) : ts_hi; ++nts; } } while (0)
    PG8_STAMP();
    unsigned voffA[2], voffB[2];
#pragma unroll
    for (int i = 0; i < 2; ++i) { int R, C; stage_rc(tid * 16 + i * 8192, R, C); const int Rb = Epi::PERM ? ((R & ~31) + perm32(R & 31)) : R;
        voffA[i] = (unsigned)(R * K + C) * 2u; voffB[i] = (unsigned)(Rb * K + C) * 2u; }
    const size_t kstep = (size_t)(BK * 2);
    const size_t hstep = (size_t)HALF * K * 2;
    const size_t tstep = 2 * hstep;
    const unsigned ldsw = (unsigned)wid * 1024u;
    const int aoff = lds_byte(wr * 64 + fr, fq * 8), boff = lds_byte(wc * 32 + fr, fq * 8);
#define PG8_SA(b, h) (((b) * 2 + (h)) * HTB)
#define PG8_SB(b, h) ((4 + (b) * 2 + (h)) * HTB)
#define PG8_STAGE(bufoff, gbase, voff) do { _Pragma("unroll") for (int _i = 0; _i < 2; ++_i) \
        __builtin_amdgcn_global_load_lds((const unsigned*)((const char*)(gbase) + (voff)[_i]), (PG8_LAS unsigned*)(lds + (bufoff) + ldsw + _i * 8192), 16, 0, 0); } while (0)
#define PG8_LDA(dst, b, h) do { _Pragma("unroll") for (int m = 0; m < 4; ++m) _Pragma("unroll") for (int k = 0; k < 2; ++k) dst[m][k] = *(const PG8_LAS bf16x8*)(lds + PG8_SA(b, h) + aoff + m * 2048 + k * 1024); } while (0)
#define PG8_LDB(dst, b, h) do { _Pragma("unroll") for (int n = 0; n < 2; ++n) _Pragma("unroll") for (int k = 0; k < 2; ++k) dst[n][k] = *(const PG8_LAS bf16x8*)(lds + PG8_SB(b, h) + boff + n * 2048 + k * 1024); } while (0)
#define PG8_MMA(ai, bj, At, Bt) do { __builtin_amdgcn_s_setprio(1); _Pragma("unroll") for (int m = 0; m < 4; ++m) _Pragma("unroll") for (int n = 0; n < 2; ++n) _Pragma("unroll") for (int k = 0; k < 2; ++k) \
        acc[ai][bj][m][n] = __builtin_amdgcn_mfma_f32_16x16x32_bf16(Bt[n][k], At[m][k], acc[ai][bj][m][n], 0, 0, 0); __builtin_amdgcn_s_setprio(0); } while (0)
#define PG8_WAIT_V(n) asm volatile("s_waitcnt vmcnt(" #n ")" ::: "memory")
#define PG8_WAIT_L(n) asm volatile("s_waitcnt lgkmcnt(" #n ")" ::: "memory")
#define PG8_BAR __builtin_amdgcn_s_barrier()
#define PG8_SCHED __builtin_amdgcn_sched_barrier(0)
    Unit cur, nxt; int ui = 0;
    if (!S.next(0, cur)) return;
    f32x4 acc[2][2][4][2];
#pragma unroll
    for (int a = 0; a < 2; ++a)
#pragma unroll
        for (int b = 0; b < 2; ++b)
#pragma unroll
            for (int m = 0; m < 4; ++m)
#pragma unroll
                for (int n = 0; n < 2; ++n) acc[a][b][m][n] = (f32x4){0.f, 0.f, 0.f, 0.f};
    bf16x8 At[4][2], B0[2][2], B1[2][2];
    const char* cA = (const char*)g.A + (size_t)cur.pm * tstep; const char* cB = (const char*)g.Bt + (size_t)cur.pn * tstep;
    S.a_ready(cur);
    PG8_STAGE(PG8_SB(0, 0), cB, voffB); PG8_STAGE(PG8_SA(0, 0), cA, voffA); PG8_STAGE(PG8_SB(0, 1), cB + hstep, voffB); PG8_STAGE(PG8_SA(0, 1), cA + hstep, voffA);
    if (wr == 1) PG8_BAR;
    PG8_WAIT_V(4); PG8_BAR;
    PG8_STAGE(PG8_SB(1, 0), cB + kstep, voffB); PG8_STAGE(PG8_SA(1, 0), cA + kstep, voffA); PG8_STAGE(PG8_SB(1, 1), cB + hstep + kstep, voffB);
    PG8_WAIT_V(6); PG8_BAR;
    PG8_STAMP();
    for (;;) {
        const bool has_next = S.next(ui + 1, nxt);
        const char* nA = has_next ? (const char*)g.A + (size_t)nxt.pm * tstep : cA; const char* nB = has_next ? (const char*)g.Bt + (size_t)nxt.pn * tstep : cB;
        for (int t = 0; t < nt; t += 2) {
            const bool last = (t == nt - 2);
            const char* a1 = cA + (size_t)(t + 1) * kstep;
            const char* a2 = last ? nA : cA + (size_t)(t + 2) * kstep; const char* b2 = last ? nB : cB + (size_t)(t + 2) * kstep;
            const char* a3 = a2 + kstep; const char* b3 = b2 + kstep;
            if (last && has_next) S.a_ready(nxt);
            PG8_LDB(B0, 0, 0); PG8_SCHED; PG8_LDA(At, 0, 0); PG8_STAGE(PG8_SA(1, 1), a1 + hstep, voffA);
            PG8_WAIT_L(8); PG8_BAR; PG8_WAIT_L(0); PG8_MMA(0, 0, At, B0); PG8_BAR; PG8_SCHED;
            PG8_LDB(B1, 0, 1); PG8_STAGE(PG8_SB(0, 0), b2, voffB);
            PG8_BAR; PG8_WAIT_L(0); PG8_MMA(0, 1, At, B1); PG8_BAR;
            PG8_LDA(At, 0, 1); PG8_STAGE(PG8_SA(0, 0), a2, voffA);
            PG8_BAR; PG8_WAIT_L(0); PG8_MMA(1, 0, At, B0); PG8_BAR; PG8_SCHED;
            PG8_STAGE(PG8_SB(0, 1), b2 + hstep, voffB);
            PG8_WAIT_V(6); PG8_BAR; PG8_MMA(1, 1, At, B1); PG8_BAR;
            PG8_LDB(B0, 1, 0); PG8_SCHED; PG8_LDA(At, 1, 0); PG8_STAGE(PG8_SA(0, 1), a2 + hstep, voffA);
            PG8_WAIT_L(8); PG8_BAR; PG8_WAIT_L(0); PG8_MMA(0, 0, At, B0); PG8_BAR; PG8_SCHED;
            PG8_LDB(B1, 1, 1); PG8_STAGE(PG8_SB(1, 0), b3, voffB);
            PG8_BAR; PG8_WAIT_L(0); PG8_MMA(0, 1, At, B1); PG8_BAR;
            PG8_LDA(At, 1, 1); PG8_STAGE(PG8_SA(1, 0), a3, voffA);
            PG8_BAR; PG8_WAIT_L(0); PG8_MMA(1, 0, At, B0); PG8_BAR; PG8_SCHED;
            PG8_STAGE(PG8_SB(1, 1), b3 + hstep, voffB);
            PG8_WAIT_V(6); PG8_BAR; PG8_MMA(1, 1, At, B1); PG8_BAR;
        }
        PG8_STAMP();
        if (wr == 0) PG8_BAR;
        if constexpr (!Epi::AFTER_DRAIN) { E(acc, cur, wr, wc, fr, fq); S.done(cur); }
        PG8_STAMP();
        if (!has_next) break;
#pragma unroll
        for (int a = 0; a < 2; ++a)
#pragma unroll
            for (int b = 0; b < 2; ++b)
#pragma unroll
                for (int m = 0; m < 4; ++m)
#pragma unroll
                    for (int n = 0; n < 2; ++n) acc[a][b][m][n] = (f32x4){0.f, 0.f, 0.f, 0.f};
        cur = nxt; cA = nA; cB = nB; ++ui;
        if (wr == 1) PG8_BAR;
    }
    PG8_WAIT_V(0);
    PG8_BAR;
    if constexpr (Epi::AFTER_DRAIN) { E.fused(acc, cur, wr, wc, fr, fq, lds, wid, lane); S.done(cur); }
    PG8_STAMP();
    if (STAMP && wid == 0) { stamps[lane] = lane < nts ? (((unsigned long long)(unsigned)ts_hi << 32) | (unsigned)ts_lo) : 0ull;
        if (lane == 62) stamps[62] = rt_entry; if (lane == 63) stamps[63] = (unsigned long long)wall_clock64(); }
#undef PG8_STAMP
#undef PG8_SA
#undef PG8_SB
#undef PG8_STAGE
#undef PG8_LDA
#undef PG8_LDB
#undef PG8_MMA
#undef PG8_WAIT_V
#undef PG8_WAIT_L
#undef PG8_BAR
#undef PG8_SCHED
}
}

using pg8::bf16_t;
using pg8::f32x4;
using pg8::u32x4;
using pg8::Unit;
typedef short bf16x8 __attribute__((ext_vector_type(8)));
typedef float f32x16 __attribute__((ext_vector_type(16)));
typedef unsigned u32x2 __attribute__((ext_vector_type(2)));
typedef short s16x4 __attribute__((ext_vector_type(4)));

#ifndef ENMASK
#define ENMASK 0xffff
#endif
#define EN(k) ((ENMASK >> (k)) & 1)
#ifndef REPMASK
#define REPMASK 0
#endif
#define NREP(k) (1 + ((REPMASK >> (k)) & 1))
#ifndef EXTRA_N
#define EXTRA_N 0
#endif
#ifndef EXTRA_Q
#define EXTRA_Q 5
#endif
constexpr int T_ = 32768, S_ = 2048;
constexpr float EPSV = 1e-6f;
constexpr float LOG2E = 1.4426950408889634f;
constexpr size_t MiB = (size_t)1 << 20;
constexpr size_t WS_COSA = 0, WS_SINA = 128 * 1024, WS_COSB = 256 * 1024, WS_SINB = 512 * 1024;
constexpr size_t WS_SSQ = 1 * MiB;
constexpr size_t WS_W = 2 * MiB;
constexpr size_t W_IN = WS_W, W_UP = WS_W + 8 * MiB, W_EOUT = WS_W + 11 * MiB, W_QKV = WS_W + 15 * MiB, W_OOUT = WS_W + 27 * MiB, W_GU = WS_W + 31 * MiB, W_DN = WS_W + 75 * MiB;
constexpr size_t SZ_IN = 4 * MiB, SZ_UP = 3 * MiB / 2, SZ_EOUT = 2 * MiB, SZ_QKV = 6 * MiB, SZ_OOUT = 2 * MiB, SZ_GU = 11 * MiB, SZ_DN = 11 * MiB / 2;
constexpr size_t WS_XN = 100 * MiB, WS_O = 164 * MiB, WS_R = 228 * MiB;
constexpr size_t R_QB = WS_R, R_KB = WS_R + 32 * MiB, R_VBT = WS_R + 64 * MiB, R_A2 = WS_R + 96 * MiB, R_KPE = WS_R + 120 * MiB, R_QA = WS_R + 122 * MiB, R_KA = WS_R + 170 * MiB, R_VAT = WS_R + 202 * MiB;
constexpr size_t R_QC = WS_R, R_KC = WS_R + 64 * MiB, R_VCT = WS_R + 128 * MiB;
constexpr size_t R_HFF = WS_R;
constexpr size_t R_VB = WS_R + 234 * MiB;
constexpr size_t WS_NSSQ = WS_R + 266 * MiB;
constexpr size_t WS_END = WS_NSSQ + 2 * MiB;
constexpr size_t WS_BAR = 896 * 1024;

struct Params {
    const float* in[17];
    float* out;
    unsigned char* ws;
};

__device__ __forceinline__ unsigned cvt_pk_bf16(float lo, float hi) { unsigned r; asm("v_cvt_pk_bf16_f32 %0, %1, %2" : "=v"(r) : "v"(lo), "v"(hi)); return r; }
__device__ __forceinline__ bf16_t f2bf(float f) { return (bf16_t)(cvt_pk_bf16(f, 0.f) & 0xffffu); }
__device__ __forceinline__ float xshfl(float v, int lane, int mask) { return __builtin_bit_cast(float, __builtin_amdgcn_ds_bpermute((lane ^ mask) << 2, __builtin_bit_cast(int, v))); }
__device__ __forceinline__ float fexp2(float x) { return __builtin_amdgcn_exp2f(x); }
__device__ __forceinline__ u32x2 pk4(f32x4 v) { u32x2 o; o.x = cvt_pk_bf16(v[0], v[1]); o.y = cvt_pk_bf16(v[2], v[3]); return o; }
__device__ __forceinline__ u32x4 pk8(f32x4 a, f32x4 b) { u32x4 o; o.x = cvt_pk_bf16(a[0], a[1]); o.y = cvt_pk_bf16(a[2], a[3]); o.z = cvt_pk_bf16(b[0], b[1]); o.w = cvt_pk_bf16(b[2], b[3]); return o; }


#define XB_TMO      128
#define XB_XCNT(j)  (256  + 64 * (j))
#define XB_XSUB(j)  (1280 + 64 * (j))
#define XB_XGEN(j)  (2304 + 64 * (j))
#define XB_TOP      3328
#define XB_TOPGEN   3392
#define XCD_BAR_WORDS 3456
#define XB_SPIN_CAP (1u << 20)
__device__ __forceinline__ unsigned xb_ld(unsigned* p)              { return __hip_atomic_load(p, __ATOMIC_RELAXED, __HIP_MEMORY_SCOPE_AGENT); }
__device__ __forceinline__ unsigned xb_add(unsigned* p, unsigned v) { return __hip_atomic_fetch_add(p, v, __ATOMIC_RELAXED, __HIP_MEMORY_SCOPE_AGENT); }
__device__ __forceinline__ unsigned xb_xcc_id() { return (unsigned)__builtin_amdgcn_s_getreg((3 << 11) | 20) & 0xFu; }
#define XB_SPIN(cond, bar) do { unsigned _sp = 0; while (cond) { __builtin_amdgcn_s_sleep(1); \
    if ((++_sp & 255u) == 0u) { if (xb_ld(&(bar)[XB_TMO])) break; if (_sp > XB_SPIN_CAP) { atomicAdd(&(bar)[XB_TMO], 1u); break; } } } } while (0)
__device__ __forceinline__ void xcd_barrier_complete(unsigned* bar, unsigned x, unsigned& nloc, unsigned& nx) {
    const unsigned G = gridDim.x;
    unsigned sum, cnt, mine, sp = 0u;
    for (;;) {
        sum = 0u; cnt = 0u; mine = 0u;
#pragma unroll
        for (unsigned j = 0; j < 16; ++j) { const unsigned c = xb_ld(&bar[XB_XCNT(j)]); sum += c; cnt += (c > 0u) ? 1u : 0u; mine = (j == x) ? c : mine; }
        if (sum == G) break;
        __builtin_amdgcn_s_sleep(1);
        if ((++sp & 255u) == 0u) { if (xb_ld(&bar[XB_TMO])) break; if (sp > XB_SPIN_CAP) { atomicAdd(&bar[XB_TMO], 1u); break; } }
    }
    nloc = mine > 0u ? mine : 1u; nx = cnt > 0u ? cnt : 1u;
}
__device__ __forceinline__ void xcd_barrier(unsigned* bar, unsigned x, volatile PG8_LAS unsigned* st, int tid) {
    asm volatile("s_waitcnt vmcnt(0)" ::: "memory");
    __syncthreads();
    if (tid == 0) {
        __builtin_amdgcn_s_waitcnt(0);
        unsigned nloc = st[0], nx = st[1];
        if (nloc == 0u) { xcd_barrier_complete(bar, x, nloc, nx); st[0] = nloc; st[1] = nx; }
        const unsigned old = xb_add(&bar[XB_XSUB(x)], 1u);
        const unsigned gen = old / nloc;
        if (old + 1u == (gen + 1u) * nloc) {
            __builtin_amdgcn_fence(__ATOMIC_RELEASE, "agent");
            asm volatile("s_waitcnt vmcnt(0)" ::: "memory");
            const unsigned og = xb_add(&bar[XB_TOP], 1u);
            const unsigned tg = og / nx;
            if (og + 1u == (tg + 1u) * nx) xb_add(&bar[XB_TOPGEN], 1u);
            else XB_SPIN(xb_ld(&bar[XB_TOPGEN]) == tg, bar);
            __builtin_amdgcn_fence(__ATOMIC_ACQUIRE, "agent");
            xb_add(&bar[XB_XGEN(x)], 1u);
            asm volatile("s_waitcnt vmcnt(0)" ::: "memory");
        } else {
            XB_SPIN(xb_ld(&bar[XB_XGEN(x)]) == gen, bar);
            __builtin_amdgcn_fence(__ATOMIC_ACQUIRE, "agent");
            asm volatile("s_waitcnt vmcnt(0)" ::: "memory");
        }
    }
    __syncthreads();
}

__device__ __forceinline__ void row_rs8(const float* __restrict__ nssq, int row0, int fr, int fq, float (&rs)[2][4]) {
    f32x4 part[2][4];
#pragma unroll
    for (int ai = 0; ai < 2; ++ai)
#pragma unroll
        for (int m = 0; m < 4; ++m) part[ai][m] = *(const f32x4*)(nssq + (size_t)(row0 + ai * 128 + m * 16) * 16 + 4 * fq);
#pragma unroll
    for (int ai = 0; ai < 2; ++ai)
#pragma unroll
        for (int m = 0; m < 4; ++m) { float s = part[ai][m][0] + part[ai][m][1] + part[ai][m][2] + part[ai][m][3];
            s += xshfl(s, fr + 16 * fq, 16); s += xshfl(s, fr + 16 * fq, 32);
            rs[ai][m] = rsqrtf(s * (1.f / 1024.f) + EPSV); }
}
struct EpiResid {
    static constexpr bool PERM = false, AFTER_DRAIN = false;
    const float* x0; bf16_t* xn; float* nssq;
    __device__ __forceinline__ void operator()(const f32x4 (&acc)[2][2][4][2], const Unit& u, int wr, int wc, int fr, int fq) const {
        asm volatile("" : "+v"(fr), "+v"(fq));
        const int row0 = u.pm * 256 + wr * 64 + fr, col0 = u.pn * 256 + wc * 32 + 8 * fq;
        float ssv[2][4];
#pragma unroll
        for (int ai = 0; ai < 2; ++ai) {
            f32x4 hv[4][2][2];
            if (x0) {
#pragma unroll
                for (int m = 0; m < 4; ++m)
#pragma unroll
                    for (int bj = 0; bj < 2; ++bj)
#pragma unroll
                        for (int n = 0; n < 2; ++n) hv[m][bj][n] = *(const f32x4*)(x0 + (size_t)(row0 + ai * 128 + m * 16) * 1024 + col0 + bj * 128 + n * 4);
            } else {
                u32x4 hb[4][2];
#pragma unroll
                for (int m = 0; m < 4; ++m)
#pragma unroll
                    for (int bj = 0; bj < 2; ++bj) hb[m][bj] = *(const u32x4*)(xn + (size_t)(row0 + ai * 128 + m * 16) * 1024 + col0 + bj * 128);
#pragma unroll
                for (int m = 0; m < 4; ++m)
#pragma unroll
                    for (int bj = 0; bj < 2; ++bj) { const u32x4 t = hb[m][bj]; f32x4 v0, v1;
                        v0[0] = __uint_as_float(t.x << 16); v0[1] = __uint_as_float(t.x & 0xffff0000u); v0[2] = __uint_as_float(t.y << 16); v0[3] = __uint_as_float(t.y & 0xffff0000u);
                        v1[0] = __uint_as_float(t.z << 16); v1[1] = __uint_as_float(t.z & 0xffff0000u); v1[2] = __uint_as_float(t.w << 16); v1[3] = __uint_as_float(t.w & 0xffff0000u);
                        hv[m][bj][0] = v0; hv[m][bj][1] = v1; }
            }
#pragma unroll
            for (int m = 0; m < 4; ++m) { const int row = row0 + ai * 128 + m * 16; float ss = 0.f;
#pragma unroll
                for (int bj = 0; bj < 2; ++bj) { const u32x4 pk = pk8(hv[m][bj][0] + acc[ai][bj][m][0], hv[m][bj][1] + acc[ai][bj][m][1]);
                    *(u32x4*)(xn + (size_t)row * 1024 + col0 + bj * 128) = pk;
                    const float r0 = __uint_as_float(pk.x << 16), r1 = __uint_as_float(pk.x & 0xffff0000u), r2 = __uint_as_float(pk.y << 16), r3 = __uint_as_float(pk.y & 0xffff0000u);
                    const float r4 = __uint_as_float(pk.z << 16), r5 = __uint_as_float(pk.z & 0xffff0000u), r6 = __uint_as_float(pk.w << 16), r7 = __uint_as_float(pk.w & 0xffff0000u);
                    ss += r0 * r0 + r1 * r1 + r2 * r2 + r3 * r3 + r4 * r4 + r5 * r5 + r6 * r6 + r7 * r7; }
                ss += xshfl(ss, fr + 16 * fq, 16); ss += xshfl(ss, fr + 16 * fq, 32);
                ssv[ai][m] = ss; }
            __builtin_amdgcn_sched_barrier(0);
        }
#pragma unroll
        for (int ai = 0; ai < 2; ++ai) { const float v = fq == 0 ? ssv[ai][0] : fq == 1 ? ssv[ai][1] : fq == 2 ? ssv[ai][2] : ssv[ai][3];
            nssq[(size_t)(row0 + ai * 128 + fq * 16) * 16 + 4 * u.pn + wc] = v; }
    }
};
struct EpiGateUp {
    static constexpr bool PERM = false, AFTER_DRAIN = false;
    bf16_t* hff; const float* nssq;
    __device__ __forceinline__ void operator()(const f32x4 (&acc)[2][2][4][2], const Unit& u, int wr, int wc, int fr, int fq) const {
        asm volatile("" : "+v"(fr), "+v"(fq));
        const int row0 = u.pm * 256 + wr * 64 + fr, fcol = u.pn * 128 + wc * 32 + 8 * fq;
        float rs8[2][4]; row_rs8(nssq, row0, fr, fq, rs8);
#pragma unroll
        for (int ai = 0; ai < 2; ++ai)
#pragma unroll
            for (int m = 0; m < 4; ++m) {
                const float rs = rs8[ai][m];
                f32x4 r0, r1;
#pragma unroll
                for (int j = 0; j < 4; ++j) {
                    const float g0 = acc[ai][0][m][0][j] * rs, g1 = acc[ai][0][m][1][j] * rs;
                    r0[j] = g0 * __builtin_amdgcn_rcpf(1.f + fexp2(-g0 * LOG2E)) * (acc[ai][1][m][0][j] * rs);
                    r1[j] = g1 * __builtin_amdgcn_rcpf(1.f + fexp2(-g1 * LOG2E)) * (acc[ai][1][m][1][j] * rs);
                }
                *(u32x4*)(hff + (size_t)(row0 + ai * 128 + m * 16) * 2816 + fcol) = pk8(r0, r1);
            }
    }
};
struct EpiEvenIn {
    static constexpr bool PERM = false, AFTER_DRAIN = false;
    unsigned char* ws; const float* nssq;
    __device__ __forceinline__ void operator()(const f32x4 (&acc)[2][2][4][2], const Unit& u, int wr, int wc, int fr, int fq) const {
        asm volatile("" : "+v"(fr), "+v"(fq));
        bf16_t* const qb = (bf16_t*)(ws + R_QB); bf16_t* const kb = (bf16_t*)(ws + R_KB); bf16_t* const vbt = (bf16_t*)(ws + R_VBT); bf16_t* const a2 = (bf16_t*)(ws + R_A2); bf16_t* const kpe = (bf16_t*)(ws + R_KPE);
        float* const ssq = (float*)(ws + WS_SSQ); const float* const cosA = (const float*)(ws + WS_COSA); const float* const sinA = (const float*)(ws + WS_SINA); const float* const cosB = (const float*)(ws + WS_COSB); const float* const sinB = (const float*)(ws + WS_SINB);
        const int row0 = u.pm * 256 + wr * 64 + fr, pn = u.pn;
        float rs8[2][4]; row_rs8(nssq, row0, fr, fq, rs8);
        if (pn < 4) {
            bf16_t* dst = pn < 2 ? qb : kb; const float sc = pn < 2 ? 0.125f * LOG2E : 1.f;
            const int hcol = (4 * (pn & 1) + wc) * 64 + 8 * fq;
#pragma unroll
            for (int ai = 0; ai < 2; ++ai) {
                f32x4 cc[4][2], sn[4][2];
#pragma unroll
                for (int m = 0; m < 4; ++m)
#pragma unroll
                    for (int n = 0; n < 2; ++n) { const int pos = (row0 + ai * 128 + m * 16) & 2047; cc[m][n] = *(const f32x4*)(cosB + pos * 32 + 8 * fq + 4 * n); sn[m][n] = *(const f32x4*)(sinB + pos * 32 + 8 * fq + 4 * n); }
#pragma unroll
                for (int m = 0; m < 4; ++m) { const int row = row0 + ai * 128 + m * 16; const float rsc = rs8[ai][m] * sc;
                    f32x4 o1[2], o2[2];
#pragma unroll
                    for (int n = 0; n < 2; ++n) { const f32x4 x1 = acc[ai][0][m][n], x2 = acc[ai][1][m][n];
                        o1[n] = (x1 * cc[m][n] - x2 * sn[m][n]) * rsc; o2[n] = (x2 * cc[m][n] + x1 * sn[m][n]) * rsc; }
                    bf16_t* p = dst + (size_t)row * 512 + hcol;
                    *(u32x4*)p = pk8(o1[0], o1[1]); *(u32x4*)(p + 32) = pk8(o2[0], o2[1]); }
                __builtin_amdgcn_sched_barrier(0);
            }
        } else if (pn < 6) {
            bf16_t* const vb = (bf16_t*)(ws + R_VB);
#pragma unroll
            for (int ai = 0; ai < 2; ++ai)
#pragma unroll
                for (int m = 0; m < 4; ++m) { const int row = row0 + ai * 128 + m * 16, pos = row & 2047, b = row >> 11; const float rs = rs8[ai][m];
#pragma unroll
                    for (int bj = 0; bj < 2; ++bj) { const int f0 = (pn - 4) * 256 + bj * 128 + wc * 32 + 8 * fq;
                        const f32x4 y0 = acc[ai][bj][m][0] * rs, y1 = acc[ai][bj][m][1] * rs;
                        *(u32x4*)(vb + (size_t)row * 512 + f0) = pk8(y0, y1);
                    }
                    __builtin_amdgcn_sched_barrier(0); }
        } else if (pn == 6) {
            float ssv[2][4];
#pragma unroll
            for (int ai = 0; ai < 2; ++ai)
#pragma unroll
                for (int m = 0; m < 4; ++m) { const int row = row0 + ai * 128 + m * 16; float ss = 0.f; const float rs = rs8[ai][m];
#pragma unroll
                    for (int bj = 0; bj < 2; ++bj) { const f32x4 v0 = acc[ai][bj][m][0] * rs, v1 = acc[ai][bj][m][1] * rs;
#pragma unroll
                        for (int j = 0; j < 4; ++j) ss += v0[j] * v0[j] + v1[j] * v1[j];
                        *(u32x4*)(a2 + (size_t)row * 384 + bj * 128 + wc * 32 + 8 * fq) = pk8(v0, v1); }
                    ss += xshfl(ss, fr + 16 * fq, 16); ss += xshfl(ss, fr + 16 * fq, 32);
                    ssv[ai][m] = ss; }
#pragma unroll
            for (int ai = 0; ai < 2; ++ai) ssq[(size_t)(row0 + ai * 128 + fq * 16) * 8 + wc] = fq == 0 ? ssv[ai][0] : fq == 1 ? ssv[ai][1] : fq == 2 ? ssv[ai][2] : ssv[ai][3];
        } else {
            float ssv[2][4];
#pragma unroll
            for (int ai = 0; ai < 2; ++ai) {
                f32x4 cc[4], sn[4];
                if (wc == 0) {
#pragma unroll
                    for (int m = 0; m < 4; ++m) { const int pos = (row0 + ai * 128 + m * 16) & 2047; cc[m] = *(const f32x4*)(cosA + pos * 16 + 4 * fq); sn[m] = *(const f32x4*)(sinA + pos * 16 + 4 * fq); }
                }
#pragma unroll
                for (int m = 0; m < 4; ++m) { const int row = row0 + ai * 128 + m * 16; float ss = 0.f; const float rs = rs8[ai][m];
                    { const f32x4 v0 = acc[ai][0][m][0] * rs, v1 = acc[ai][0][m][1] * rs;
#pragma unroll
                      for (int j = 0; j < 4; ++j) ss += v0[j] * v0[j] + v1[j] * v1[j];
                      *(u32x4*)(a2 + (size_t)row * 384 + 256 + wc * 32 + 8 * fq) = pk8(v0, v1); }
                    ss += xshfl(ss, fr + 16 * fq, 16); ss += xshfl(ss, fr + 16 * fq, 32);
                    ssv[ai][m] = ss;
                    if (wc == 0) { const f32x4 x1 = acc[ai][1][m][0] * rs, x2 = acc[ai][1][m][1] * rs;
                        bf16_t* p = kpe + (size_t)row * 32 + 4 * fq;
                        *(u32x2*)p = pk4(x1 * cc[m] - x2 * sn[m]); *(u32x2*)(p + 16) = pk4(x2 * cc[m] + x1 * sn[m]); } }
                __builtin_amdgcn_sched_barrier(0);
            }
#pragma unroll
            for (int ai = 0; ai < 2; ++ai) ssq[(size_t)(row0 + ai * 128 + fq * 16) * 8 + 4 + wc] = fq == 0 ? ssv[ai][0] : fq == 1 ? ssv[ai][1] : fq == 2 ? ssv[ai][2] : ssv[ai][3];
        }
    }
};
struct EpiEvenUp {
    static constexpr bool PERM = false, AFTER_DRAIN = false;
    unsigned char* ws;
    __device__ __forceinline__ void operator()(const f32x4 (&acc)[2][2][4][2], const Unit& u, int wr, int wc, int fr, int fq) const {
        asm volatile("" : "+v"(fr), "+v"(fq));
        bf16_t* const qa = (bf16_t*)(ws + R_QA); bf16_t* const ka = (bf16_t*)(ws + R_KA); bf16_t* const vat = (bf16_t*)(ws + R_VAT);
        const float* const ssq = (const float*)(ws + WS_SSQ); const float* const cosA = (const float*)(ws + WS_COSA); const float* const sinA = (const float*)(ws + WS_SINA);
        const int row0 = u.pm * 256 + wr * 64 + fr, pn = u.pn;
        float rs8[2][4];
        { f32x4 q[2][4];
#pragma unroll
          for (int ai = 0; ai < 2; ++ai)
#pragma unroll
              for (int m = 0; m < 4; ++m) q[ai][m] = *(const f32x4*)(ssq + (size_t)(row0 + ai * 128 + m * 16) * 8 + (pn < 3 ? 0 : 4));
          const float dinv = pn < 3 ? (1.f / 256.f) : (1.f / 128.f), mul = pn < 3 ? (0.10206207261596575f * LOG2E) : 1.f;
#pragma unroll
          for (int ai = 0; ai < 2; ++ai)
#pragma unroll
              for (int m = 0; m < 4; ++m) rs8[ai][m] = rsqrtf((q[ai][m][0] + q[ai][m][1] + q[ai][m][2] + q[ai][m][3]) * dinv + EPSV) * mul; }
        if (pn < 3) {
            int hoff[2], part[2];
#pragma unroll
            for (int bj = 0; bj < 2; ++bj) { const int G = 8 * pn + 4 * bj + wc, head = G / 3; part[bj] = G - 3 * head; hoff[bj] = head * 96 + (part[bj] < 2 ? 32 * part[bj] + 8 * fq : 64 + 4 * fq); }
            const bool anyrope = (part[0] == 2) || (part[1] == 2);
#pragma unroll
            for (int ai = 0; ai < 2; ++ai) {
                f32x4 cc[4], sn[4];
                if (anyrope) {
#pragma unroll
                    for (int m = 0; m < 4; ++m) { const int pos = (row0 + ai * 128 + m * 16) & 2047; cc[m] = *(const f32x4*)(cosA + pos * 16 + 4 * fq); sn[m] = *(const f32x4*)(sinA + pos * 16 + 4 * fq); }
                }
#pragma unroll
                for (int m = 0; m < 4; ++m) { const int row = row0 + ai * 128 + m * 16; const float rs = rs8[ai][m];
#pragma unroll
                    for (int bj = 0; bj < 2; ++bj) {
                        const f32x4 x1 = acc[ai][bj][m][0] * rs, x2 = acc[ai][bj][m][1] * rs;
                        bf16_t* p = qa + (size_t)row * 768 + hoff[bj];
                        if (part[bj] < 2) *(u32x4*)p = pk8(x1, x2);
                        else { *(u32x2*)p = pk4(x1 * cc[m] - x2 * sn[m]); *(u32x2*)(p + 16) = pk4(x2 * cc[m] + x1 * sn[m]); } } }
                __builtin_amdgcn_sched_barrier(0);
            }
        } else {
            int head[2], part[2];
#pragma unroll
            for (int bj = 0; bj < 2; ++bj) { const int G = 8 * (pn - 3) + 4 * bj + wc; head[bj] = G >> 2; part[bj] = G & 3; }
#pragma unroll
            for (int ai = 0; ai < 2; ++ai)
#pragma unroll
                for (int m = 0; m < 4; ++m) { const int row = row0 + ai * 128 + m * 16, pos = row & 2047, b = row >> 11; const float rs = rs8[ai][m];
#pragma unroll
                    for (int bj = 0; bj < 2; ++bj) {
                        const f32x4 x1 = acc[ai][bj][m][0] * rs, x2 = acc[ai][bj][m][1] * rs;
                        if (part[bj] < 2) *(u32x4*)(ka + (size_t)row * 512 + head[bj] * 64 + 32 * part[bj] + 8 * fq) = pk8(x1, x2);
                        else *(u32x4*)(vat + (size_t)row * 512 + head[bj] * 64 + 32 * (part[bj] - 2) + 8 * fq) = pk8(x1, x2); }
                    __builtin_amdgcn_sched_barrier(0); }
        }
    }
};
struct EpiOddQKV {
    static constexpr bool PERM = false, AFTER_DRAIN = false;
    unsigned char* ws; const float* nssq;
    __device__ __forceinline__ void operator()(const f32x4 (&acc)[2][2][4][2], const Unit& u, int wr, int wc, int fr, int fq) const {
        asm volatile("" : "+v"(fr), "+v"(fq));
        bf16_t* const qc = (bf16_t*)(ws + R_QC); bf16_t* const kc = (bf16_t*)(ws + R_KC); bf16_t* const vct = (bf16_t*)(ws + R_VCT);
        const int row0 = u.pm * 256 + wr * 64 + fr, pn = u.pn;
        float rs8[2][4]; row_rs8(nssq, row0, fr, fq, rs8);
        if (pn < 8) {
            bf16_t* dst = pn < 4 ? qc : kc; const float sc = pn < 4 ? 0.125f * LOG2E : 1.f;
#pragma unroll
            for (int ai = 0; ai < 2; ++ai)
#pragma unroll
                for (int m = 0; m < 4; ++m) { const int row = row0 + ai * 128 + m * 16; const float rsc = rs8[ai][m] * sc;
#pragma unroll
                    for (int bj = 0; bj < 2; ++bj)
                        *(u32x4*)(dst + (size_t)row * 1024 + (pn & 3) * 256 + bj * 128 + wc * 32 + 8 * fq) = pk8(acc[ai][bj][m][0] * rsc, acc[ai][bj][m][1] * rsc); }
        } else {
#pragma unroll
            for (int ai = 0; ai < 2; ++ai)
#pragma unroll
                for (int m = 0; m < 4; ++m) { const int row = row0 + ai * 128 + m * 16; const float rs = rs8[ai][m];
#pragma unroll
                    for (int bj = 0; bj < 2; ++bj)
                        *(u32x4*)(vct + (size_t)row * 1024 + (pn - 8) * 256 + bj * 128 + wc * 32 + 8 * fq) = pk8(acc[ai][bj][m][0] * rs, acc[ai][bj][m][1] * rs); }
        }
    }
};

enum { MAP_IDENT = 0, MAP_EVIN, MAP_QUP, MAP_KVUP, MAP_ODQKV, MAP_GU, MAP_P32 };
__device__ __forceinline__ int p32(int w) { return (w & ~31) + pg8::perm32(w & 31); }
__device__ __forceinline__ int src_col(int map, int c, int sel) {
    switch (map) {
    case MAP_EVIN: { const int pn = c >> 8, w = c & 255;
        if (pn < 4) { const int bj = w >> 7, wc = (w >> 5) & 3, d = pg8::perm32(w & 31) + 32 * bj, head = 4 * (pn & 1) + wc; return 416 + (pn >> 1) * 512 + head * 64 + d; }
        if (pn < 6) return 416 + 1024 + (pn - 4) * 256 + p32(w);
        if (pn == 6) return p32(w);
        if (w < 128) return 256 + p32(w);
        if (w < 160) return 384 + (w - 128);
        return -1; }
    case MAP_QUP: { const int G = c >> 5, head = G / 3, part = G - 3 * head, rho = c & 31; return part < 2 ? head * 96 + 32 * part + pg8::perm32(rho) : head * 96 + 64 + rho; }
    case MAP_KVUP: { const int G = c >> 5, head = G >> 2, part = G & 3, rho = c & 31; return head * 128 + 32 * part + pg8::perm32(rho); }
    case MAP_ODQKV: { const int which = c >> 10, f = c & 1023; return which * 1024 + p32(f); }
    case MAP_GU: { const int pn = c >> 8, bj = (c >> 7) & 1, w = c & 127; if (bj != sel) return -2; return 128 * pn + p32(w); }
    case MAP_P32: return p32(c);
    default: return c;
    }
}
__device__ __forceinline__ void prep_w(int& rot, float* tl, const float* __restrict__ W, int Nsrc, int Ksrc, const float* __restrict__ gain, bf16_t* Bt, int Kt, int klo, int row0, int nrows, int map, int sel) {
    const int tid = threadIdx.x, nkt = Kt >> 7, ntile = (nrows >> 6) * nkt;
    const int G = (int)gridDim.x; int t0 = (int)blockIdx.x - rot; if (t0 < 0) t0 += G;
    rot = (rot + ntile) % G;
    for (int t = t0; t < ntile; t += G) {
        const int tr = t / nkt, tk = t - tr * nkt;
        if (map == MAP_GU && src_col(map, tr * 64, sel) == -2) continue;
        { const int c = tid & 63, kq = tid >> 6, src = src_col(map, tr * 64 + c, sel);
          float v[16];
#pragma unroll
          for (int i = 0; i < 16; ++i) { const int ks = tk * 128 + kq * 16 + i - klo; v[i] = 0.f;
              if (src >= 0 && ks >= 0 && ks < Ksrc) v[i] = W[(size_t)ks * Nsrc + src]; }
          if (gain) {
#pragma unroll
              for (int i = 0; i < 16; ++i) { const int ks = tk * 128 + kq * 16 + i - klo; if (src >= 0 && ks >= 0 && ks < Ksrc) v[i] *= gain[ks]; } }
#pragma unroll
          for (int i = 0; i < 16; ++i) tl[(kq * 16 + i) * 65 + c] = v[i]; }
        __syncthreads();
#pragma unroll
        for (int half = 0; half < 2; ++half) { const int kc = tid & 15, c = (tid >> 4) + 32 * half; float v[8];
#pragma unroll
          for (int i = 0; i < 8; ++i) v[i] = tl[(kc * 8 + i) * 65 + c];
          u32x4 o; o.x = cvt_pk_bf16(v[0], v[1]); o.y = cvt_pk_bf16(v[2], v[3]); o.z = cvt_pk_bf16(v[4], v[5]); o.w = cvt_pk_bf16(v[6], v[7]);
          *(u32x4*)(Bt + (size_t)(row0 + tr * 64 + c) * Kt + tk * 128 + kc * 8) = o; }
        __syncthreads();
    }
}

__device__ __forceinline__ void norm_phase(const float* __restrict__ h, bf16_t* xn, float* outf, const float* __restrict__ g, float* ssq_out, int gw, int nw, int lane) {
    for (int row = gw; row < T_; row += nw) {
        const f32x4* p = (const f32x4*)(h + (size_t)row * 1024);
        f32x4 v[4]; float ss = 0.f;
#pragma unroll
        for (int i = 0; i < 4; ++i) { v[i] = p[lane + 64 * i]; ss += v[i][0] * v[i][0] + v[i][1] * v[i][1] + v[i][2] * v[i][2] + v[i][3] * v[i][3]; }
#pragma unroll
        for (int o = 32; o >= 1; o >>= 1) ss += xshfl(ss, lane, o);
        const float rs = rsqrtf(ss * (1.f / 1024.f) + EPSV);
        if (outf) {
#pragma unroll
            for (int i = 0; i < 4; ++i) { const f32x4 gg = *(const f32x4*)(g + 4 * (lane + 64 * i)); *(f32x4*)(outf + (size_t)row * 1024 + 4 * (lane + 64 * i)) = v[i] * rs * gg; }
        } else {
#pragma unroll
            for (int i = 0; i < 4; ++i) *(u32x2*)(xn + (size_t)row * 1024 + 4 * (lane + 64 * i)) = pk4(v[i]);
            if (lane < 16) ssq_out[row * 16 + lane] = lane == 0 ? ss : 0.f;
        }
    }
}

__device__ __forceinline__ void final_norm_phase(const bf16_t* __restrict__ xn, float* outf, const float* __restrict__ g, int gw, int nw, int lane) {
    for (int row = gw; row < T_; row += nw) {
        const u32x4* p = (const u32x4*)(xn + (size_t)row * 1024);
        f32x4 v[4]; float ss = 0.f;
#pragma unroll
        for (int i = 0; i < 2; ++i) { const u32x4 t = p[lane + 64 * i];
            v[2 * i][0] = __uint_as_float(t.x << 16); v[2 * i][1] = __uint_as_float(t.x & 0xffff0000u); v[2 * i][2] = __uint_as_float(t.y << 16); v[2 * i][3] = __uint_as_float(t.y & 0xffff0000u);
            v[2 * i + 1][0] = __uint_as_float(t.z << 16); v[2 * i + 1][1] = __uint_as_float(t.z & 0xffff0000u); v[2 * i + 1][2] = __uint_as_float(t.w << 16); v[2 * i + 1][3] = __uint_as_float(t.w & 0xffff0000u); }
#pragma unroll
        for (int i = 0; i < 4; ++i) ss += v[i][0] * v[i][0] + v[i][1] * v[i][1] + v[i][2] * v[i][2] + v[i][3] * v[i][3];
#pragma unroll
        for (int o = 32; o >= 1; o >>= 1) ss += xshfl(ss, lane, o);
        const float rs = rsqrtf(ss * (1.f / 1024.f) + EPSV);
#pragma unroll
        for (int i = 0; i < 2; ++i) { const int c0 = 8 * (lane + 64 * i);
            *(f32x4*)(outf + (size_t)row * 1024 + c0) = v[2 * i] * rs * *(const f32x4*)(g + c0);
            *(f32x4*)(outf + (size_t)row * 1024 + c0 + 4) = v[2 * i + 1] * rs * *(const f32x4*)(g + c0 + 4); }
    }
}

#define MFMA32(a, b, c) __builtin_amdgcn_mfma_f32_32x32x16_bf16(a, b, c, 0, 0, 0)
__device__ __forceinline__ bf16x8 mk8(u32x2 a, u32x2 b) { u32x4 t; t.x = a.x; t.y = a.y; t.z = b.x; t.w = b.y; return __builtin_bit_cast(bf16x8, t); }
typedef float f32x8v __attribute__((ext_vector_type(8)));
typedef float f32x2v __attribute__((ext_vector_type(2)));
__device__ __forceinline__ void softmax_pv(const f32x16& s, f32x16& o0, f32x16& o1, float& m, float& l, const bf16x8 v00, const bf16x8 v01, const bf16x8 v10, const bf16x8 v11, int lane, bool& fresh) {
    if (fresh) {
        float mx = s[0];
#pragma unroll
        for (int i = 1; i < 16; ++i) mx = fmaxf(mx, s[i]);
        mx = fmaxf(mx, xshfl(mx, lane, 32));
        m = fmaxf(mx, -16.f);
        fresh = false;
    }
    const f32x16 t = s - m;
    f32x16 p;
#pragma unroll
    for (int i = 0; i < 16; ++i) p[i] = fexp2(t[i]);
    const f32x8v a8 = p.lo + p.hi; const f32x4 a4 = a8.lo + a8.hi; const f32x2v a2 = a4.lo + a4.hi;
    l += a2.x + a2.y;
    u32x4 a, b;
    a.x = cvt_pk_bf16(p[0], p[1]); a.y = cvt_pk_bf16(p[2], p[3]); a.z = cvt_pk_bf16(p[4], p[5]); a.w = cvt_pk_bf16(p[6], p[7]);
    b.x = cvt_pk_bf16(p[8], p[9]); b.y = cvt_pk_bf16(p[10], p[11]); b.z = cvt_pk_bf16(p[12], p[13]); b.w = cvt_pk_bf16(p[14], p[15]);
    const bf16x8 pk0 = __builtin_bit_cast(bf16x8, a), pk1 = __builtin_bit_cast(bf16x8, b);
    o0 = MFMA32(v00, pk0, o0); o0 = MFMA32(v01, pk1, o0);
    o1 = MFMA32(v10, pk0, o1); o1 = MFMA32(v11, pk1, o1);
}
__device__ __forceinline__ void attn_store(int lane, const f32x16& o0, const f32x16& o1, float l, bf16_t* op  ) {
    const float inv = 1.f / (l + xshfl(l, lane, 32));
#pragma unroll
    for (int g = 0; g < 4; ++g) {
        u32x2 a, b;
        a.x = cvt_pk_bf16(o0[4 * g] * inv, o0[4 * g + 1] * inv); a.y = cvt_pk_bf16(o0[4 * g + 2] * inv, o0[4 * g + 3] * inv);
        b.x = cvt_pk_bf16(o1[4 * g] * inv, o1[4 * g + 1] * inv); b.y = cvt_pk_bf16(o1[4 * g + 2] * inv, o1[4 * g + 3] * inv);
        *(u32x2*)(op + 8 * g) = a; *(u32x2*)(op + 32 + 8 * g) = b;
    }
}
__device__ __forceinline__ void load_vt(const bf16_t* vrow, bf16x8& v00, bf16x8& v01, bf16x8& v10, bf16x8& v11) {
    v00 = mk8(*(const u32x2*)(vrow), *(const u32x2*)(vrow + 8)); v01 = mk8(*(const u32x2*)(vrow + 16), *(const u32x2*)(vrow + 24));
    const bf16_t* v1 = vrow + 32 * 2048;
    v10 = mk8(*(const u32x2*)(v1), *(const u32x2*)(v1 + 8)); v11 = mk8(*(const u32x2*)(v1 + 16), *(const u32x2*)(v1 + 24));
}

#define LASP PG8_LAS unsigned char*
__device__ __forceinline__ void read_vtr(LASP vimg, int keyoff, int lane, bf16x8& v00, bf16x8& v01, bf16x8& v10, bf16x8& v11) {
    LASP base = vimg + (keyoff + 4 * (lane >> 5) + ((lane & 15) >> 2)) * 144 + (16 * ((lane >> 4) & 1) + 4 * (lane & 3)) * 2;
    bf16x8 f[2][2];
#pragma unroll
    for (int dt = 0; dt < 2; ++dt)
#pragma unroll
        for (int s = 0; s < 2; ++s) {
            const s16x4 lo = __builtin_amdgcn_ds_read_tr16_b64_v4i16((PG8_LAS s16x4*)(base + (16 * s) * 144 + 64 * dt));
            const s16x4 hi = __builtin_amdgcn_ds_read_tr16_b64_v4i16((PG8_LAS s16x4*)(base + (16 * s + 8) * 144 + 64 * dt));
            bf16x8 g; g[0] = lo[0]; g[1] = lo[1]; g[2] = lo[2]; g[3] = lo[3]; g[4] = hi[0]; g[5] = hi[1]; g[6] = hi[2]; g[7] = hi[3]; f[dt][s] = g; }
    v00 = f[0][0]; v01 = f[0][1]; v10 = f[1][0]; v11 = f[1][1];
}
template <int KD> struct StageCfg { static constexpr int KP = KD * 2 + 16, KBYTES = 64 * KP, VP = 136, VBYTES = 64 * VP, BYTES = KBYTES + VBYTES; };
struct StageRegs { u32x4 k, v, pe; };
template <int KD>
__device__ __forceinline__ void stage_issue(StageRegs& R, const bf16_t* __restrict__ krow0, int kstride, const bf16_t* __restrict__ pe0, const bf16_t* __restrict__ vt0, int tid) {
    R.k = *(const u32x4*)(krow0 + (size_t)(tid >> 3) * kstride + (tid & 7) * 8);
    R.v = *(const u32x4*)(vt0 + (size_t)(tid >> 3) * 2048 + (tid & 7) * 8);
    if (KD == 96) R.pe = *(const u32x4*)(pe0 + ((tid >> 2) & 63) * 32 + (tid & 3) * 8);
}
template <int KD>
__device__ __forceinline__ void stage_commit(LASP buf, const StageRegs& R, int tid) {
    typedef StageCfg<KD> C;
    *(PG8_LAS u32x4*)(buf + (tid >> 3) * C::KP + (tid & 7) * 16) = R.k;
    LASP vp = buf + C::KBYTES + (tid >> 3) * C::VP + (tid & 7) * 16;
    u32x2 a, b; a.x = R.v.x; a.y = R.v.y; b.x = R.v.z; b.y = R.v.w;
    *(PG8_LAS u32x2*)vp = a; *(PG8_LAS u32x2*)(vp + 8) = b;
    if (KD == 96) { if (tid < 256) *(PG8_LAS u32x4*)(buf + (tid >> 2) * C::KP + 128 + (tid & 3) * 16) = R.pe; }
}
template <int KD>
__device__ __forceinline__ void read_kf(LASP buf, int row, int h, bf16x8 (&kf)[KD / 16]) {
#pragma unroll
    for (int kk = 0; kk < KD / 16; ++kk) kf[kk] = *(const PG8_LAS bf16x8*)(buf + row * StageCfg<KD>::KP + 32 * kk + 16 * h);
}
__device__ __forceinline__ void read_vf(LASP vbuf, int r, int keyoff, bf16x8& v00, bf16x8& v01, bf16x8& v10, bf16x8& v11) {
    LASP p0 = vbuf + r * 136 + keyoff * 2; LASP p1 = p0 + 32 * 136;
    v00 = mk8(*(const PG8_LAS u32x2*)(p0), *(const PG8_LAS u32x2*)(p0 + 16)); v01 = mk8(*(const PG8_LAS u32x2*)(p0 + 32), *(const PG8_LAS u32x2*)(p0 + 48));
    v10 = mk8(*(const PG8_LAS u32x2*)(p1), *(const PG8_LAS u32x2*)(p1 + 16)); v11 = mk8(*(const PG8_LAS u32x2*)(p1 + 32), *(const PG8_LAS u32x2*)(p1 + 48));
}


template <int KD, int PD, bool ALWAYS, class Src, class Comp>
__device__ __forceinline__ void staged_loop(LASP lds, int s_lo, int s_hi, int tid, Src&& src, Comp&& comp) {
    typedef StageCfg<KD> C;
    if (s_lo >= s_hi) return;
    StageRegs R[PD];
    src(s_lo, R[0]); stage_commit<KD>(lds + (s_lo & 1) * C::BYTES, R[0], tid);
#pragma unroll
    for (int d = 1; d < PD; ++d) { if (ALWAYS) src(s_lo + d < s_hi ? s_lo + d : s_hi - 1, R[d]); else if (s_lo + d < s_hi) src(s_lo + d, R[d]); }
    __syncthreads();
    for (int st = s_lo; st < s_hi; st += PD) {
#pragma unroll
        for (int d = 0; d < PD; ++d) {
            const int s = st + d;
            if (s < s_hi) {
                if (ALWAYS) src(s + PD < s_hi ? s + PD : s_hi - 1, R[d]); else if (s + PD < s_hi) src(s + PD, R[d]);
                comp(s, lds + (s & 1) * C::BYTES);
                if (s + 1 < s_hi) stage_commit<KD>(lds + ((s + 1) & 1) * C::BYTES, R[(d + 1) % PD], tid);
                __syncthreads();
            }
        }
    }
}

__device__ __forceinline__ void mla_phase(LASP lds, const bf16_t* __restrict__ QA, const bf16_t* __restrict__ KA, const bf16_t* __restrict__ KPE, const bf16_t* __restrict__ VAT, bf16_t* O, int tid) {
    constexpr int KB_ = 64 * 208, SB = KB_ + 64 * 144 + 2 * 1024;
    const int lane = tid & 63, w = __builtin_amdgcn_readfirstlane(tid >> 6), r = lane & 31, h = lane >> 5;
    if (w >= 4) __builtin_amdgcn_s_setprio(1);
    for (int it = blockIdx.x; it < 1024; it += gridDim.x) {
        int item = it;
        if (gridDim.x == 256) { const int k = it >> 8, B = it & 255, x = B & 7, y = B >> 3; item = ((((k * 8 + x) * 4) + (y >> 3)) << 3) | (y & 7); }
        const int bh = item >> 3, qb8 = item & 7, b = bh >> 3, head = bh & 7;
        const size_t tq = (size_t)b * 2048 + qb8 * 256 + w * 32 + r;
        bf16x8 qf[6];
#pragma unroll
        for (int kk = 0; kk < 6; ++kk) qf[kk] = *(const bf16x8*)(QA + tq * 768 + head * 96 + 16 * kk + 8 * h);
        const char* src[3]; unsigned step[3]; int dst[3];
#pragma unroll
        for (int j = 0; j < 3; ++j) {
            const int p = w + 8 * j;
            if (p < 13) { const int c = 64 * p + lane, row = c / 13, col = c - 13 * row;
                if (col >= 8 && col < 12) { src[j] = (const char*)(KPE + ((size_t)b * 2048 + row) * 32 + (col - 8) * 8); step[j] = 64 * 32 * 2; }
                else { src[j] = (const char*)(KA + ((size_t)b * 2048 + row) * 512 + head * 64 + (col & 7) * 8); step[j] = 64 * 512 * 2; }
                dst[j] = p * 1024; }
            else if (p < 22) { const int c = 64 * (p - 13) + lane, row = c / 9, col = c - 9 * row;
                src[j] = (const char*)(VAT + ((size_t)b * 2048 + row) * 512 + head * 64 + (col & 7) * 8); step[j] = 64 * 512 * 2; dst[j] = KB_ + (p - 13) * 1024; }
            else { src[j] = (const char*)(KA + ((size_t)b * 2048 + lane) * 512); step[j] = 0; dst[j] = KB_ + 64 * 144 + (p - 22) * 1024; }
        }
        f32x16 o0, o1;
#pragma unroll
        for (int i = 0; i < 16; ++i) { o0[i] = 0.f; o1[i] = 0.f; }
        float m = 0.f, l = 0.f; bool fresh = true;
#define MLA_ISSUE(st) do { const int _s = (st) < 32 ? (st) : 31; LASP _b = lds + ((st) % 5) * SB; _Pragma("unroll") for (int _j = 0; _j < 3; ++_j) \
        __builtin_amdgcn_global_load_lds((const unsigned*)(src[_j] + (size_t)_s * step[_j]), (PG8_LAS unsigned*)(_b + dst[_j]), 16, 0, 0); } while (0)
        asm volatile("s_waitcnt vmcnt(0) lgkmcnt(0)" ::: "memory"); __builtin_amdgcn_s_barrier();
        MLA_ISSUE(0); MLA_ISSUE(1); MLA_ISSUE(2); MLA_ISSUE(3);
        for (int st = 0; st < 32; ++st) {
            asm volatile("s_waitcnt vmcnt(9)" ::: "memory");
            __builtin_amdgcn_s_barrier();
            asm volatile("" ::: "memory");
            MLA_ISSUE(st + 4);
            LASP buf = lds + (st % 5) * SB;
#pragma unroll
            for (int sub = 0; sub < 2; ++sub) {
                bf16x8 kf[6], v00, v01, v10, v11;
#pragma unroll
                for (int kk = 0; kk < 6; ++kk) kf[kk] = *(const PG8_LAS bf16x8*)(buf + (32 * sub + r) * 208 + 32 * kk + 16 * h);
                read_vtr(buf + KB_, 32 * sub, lane, v00, v01, v10, v11);
                __builtin_amdgcn_sched_barrier(0);
                f32x16 s;
#pragma unroll
                for (int i = 0; i < 16; ++i) s[i] = 0.f;
#pragma unroll
                for (int kk = 0; kk < 6; ++kk) s = MFMA32(kf[kk], qf[kk], s);
                softmax_pv(s, o0, o1, m, l, v00, v01, v10, v11, lane, fresh);
            }
        }
#undef MLA_ISSUE
        attn_store(lane, o0, o1, l, O + tq * 1024 + head * 64 + 4 * h);
    }
    __builtin_amdgcn_s_setprio(0);
    asm volatile("s_waitcnt vmcnt(0)" ::: "memory"); __syncthreads();
}


constexpr int D64_KB = 64 * 144, D64_SB = 2 * D64_KB + 1024;
template <int NBUF, class Comp>
__device__ __forceinline__ void dma64_loop(LASP lds, int s_lo, int s_hi, const bf16_t* kbase  , int kstride, const bf16_t* vbase  , int w, int lane, Comp&& comp) {
    const char* src[3]; unsigned step[3]; int dst[3];
#pragma unroll
    for (int j = 0; j < 3; ++j) {
        const int p = w + 8 * j;
        if (p < 9) { const int c = 64 * p + lane, row = c / 9, col = c - 9 * row; src[j] = (const char*)(kbase + (size_t)row * kstride + (col & 7) * 8); step[j] = (unsigned)(64 * kstride * 2); dst[j] = p * 1024; }
        else if (p < 18) { const int c = 64 * (p - 9) + lane, row = c / 9, col = c - 9 * row; src[j] = (const char*)(vbase + (size_t)row * kstride + (col & 7) * 8); step[j] = (unsigned)(64 * kstride * 2); dst[j] = D64_KB + (p - 9) * 1024; }
        else { src[j] = (const char*)(kbase + (size_t)lane * kstride); step[j] = 0u; dst[j] = 2 * D64_KB; }
    }
#define D64_ISSUE(st) do { const int _s = (st) < s_hi ? (st) : s_hi - 1; LASP _b = lds + (((st) - s_lo) % NBUF) * D64_SB; _Pragma("unroll") for (int _j = 0; _j < 3; ++_j) \
        __builtin_amdgcn_global_load_lds((const unsigned*)(src[_j] + (size_t)_s * step[_j]), (PG8_LAS unsigned*)(_b + dst[_j]), 16, 0, 0); } while (0)
    asm volatile("s_waitcnt vmcnt(0) lgkmcnt(0)" ::: "memory"); __builtin_amdgcn_s_barrier();
#pragma unroll
    for (int d = 0; d < NBUF - 1; ++d) D64_ISSUE(s_lo + d);
    for (int st = s_lo; st < s_hi; ++st) {
        if (NBUF == 5) asm volatile("s_waitcnt vmcnt(9)" ::: "memory"); else if (NBUF == 4) asm volatile("s_waitcnt vmcnt(6)" ::: "memory"); else asm volatile("s_waitcnt vmcnt(3)" ::: "memory");
        __builtin_amdgcn_s_barrier();
        asm volatile("" ::: "memory");
        D64_ISSUE(st + NBUF - 1);
        comp(st, lds + ((st - s_lo) % NBUF) * D64_SB);
    }
#undef D64_ISSUE
    asm volatile("s_waitcnt vmcnt(0)" ::: "memory"); __builtin_amdgcn_s_barrier();
}
__device__ __forceinline__ void d64_read(LASP buf, int krow, int lane, int keyoff, int h, bf16x8 (&kf)[4], bf16x8& v00, bf16x8& v01, bf16x8& v10, bf16x8& v11) {
#pragma unroll
    for (int kk = 0; kk < 4; ++kk) kf[kk] = *(const PG8_LAS bf16x8*)(buf + krow * 144 + 32 * kk + 16 * h);
    read_vtr(buf + D64_KB, keyoff, lane, v00, v01, v10, v11);
}

__device__ __forceinline__ void dil_phase(LASP lds, const bf16_t* __restrict__ QB, const bf16_t* __restrict__ KB, const bf16_t* __restrict__ VBT, const bf16_t* __restrict__ VB, bf16_t* O, int tid) {
    typedef StageCfg<64> C;
    const int lane = tid & 63, w = tid >> 6, r = lane & 31, h = lane >> 5;
    LASP wsc = lds + 4 * D64_SB + w * 4608;
    if (__builtin_amdgcn_readfirstlane(tid >> 6) >= 4) __builtin_amdgcn_s_setprio(1);
    for (int it = blockIdx.x; it < 1024; it += gridDim.x) {
        int item = it;
        if (gridDim.x == 256) { const int k = it >> 8, B = it & 255, x = B & 7, y = B >> 3; item = ((((k * 8 + x) * 4) + (y >> 3)) << 3) | (y & 7); }
        const int bh = item >> 3, a = (item >> 1) & 3, rr = 8 * (item & 1) + w, b = bh >> 3, head = bh & 7;
        const int tq = 512 * a + rr + 16 * r;
        bf16x8 qf[4];
#pragma unroll
        for (int kk = 0; kk < 4; ++kk) qf[kk] = *(const bf16x8*)(QB + ((size_t)b * 2048 + tq) * 512 + head * 64 + 16 * kk + 8 * h);
        f32x16 o0, o1;
#pragma unroll
        for (int i = 0; i < 16; ++i) { o0[i] = 0.f; o1[i] = 0.f; }
        float m = 0.f, l = 0.f; bool fresh = true;
        {
            const int s_lo = a == 0 ? 1 : 0, s_hi = a == 3 ? 9 : 10;
            const bf16_t* k0 = KB + ((size_t)b * 2048 + 512 * a - 64) * 512 + head * 64;
            const bf16_t* vt0 = VB + ((size_t)b * 2048 + 512 * a - 64) * 512 + head * 64;
            dma64_loop<4>(lds, s_lo, s_hi, k0, 512, vt0, __builtin_amdgcn_readfirstlane(w), lane, [&](int st, LASP buf) {
#pragma unroll
                for (int sub = 0; sub < 2; ++sub) {
                    bf16x8 kf[4], v00, v01, v10, v11;
                    d64_read(buf, 32 * sub + r, lane, 32 * sub, h, kf, v00, v01, v10, v11);
                    f32x16 s;
#pragma unroll
                    for (int i = 0; i < 16; ++i) s[i] = 0.f;
#pragma unroll
                    for (int kk = 0; kk < 4; ++kk) s = MFMA32(kf[kk], qf[kk], s);
                    const int base = 512 * a - 64 + 64 * st + 32 * sub + 4 * h - tq;
#pragma unroll
                    for (int i = 0; i < 16; ++i) { const int dd = base + 8 * (i >> 2) + (i & 3); s[i] = (dd <= 64 && dd >= -64) ? s[i] : -__builtin_inff(); }
                    softmax_pv(s, o0, o1, m, l, v00, v01, v10, v11, lane, fresh);
                }
            });
        }
        {
            const bf16_t* kb = KB + (size_t)b * 2048 * 512 + head * 64 + 8 * h;
            const bf16_t* vb = VB + (size_t)b * 2048 * 512 + head * 64 + 8 * h;
            auto tile_ok = [&](int t) -> bool { const int u0 = t < 8 ? 128 * a - 64 + 32 * t : 32 * a - 64 + 32 * (t - 8); return u0 >= 0 && u0 < (t < 8 ? 512 : 128); };
            auto tile_pos = [&](int t) -> int { return t < 8 ? 4 * (128 * a - 64 + 32 * t + r) + (rr & 3) : 16 * (32 * a - 64 + 32 * (t - 8) + r) + rr; };
            int t = 0; while (t < 13 && !tile_ok(t)) ++t;
            u32x4 kc[4], vc[4];
            if (t < 13) { const size_t kp = (size_t)tile_pos(t) * 512;
#pragma unroll
                for (int kk = 0; kk < 4; ++kk) { kc[kk] = *(const u32x4*)(kb + kp + 16 * kk); vc[kk] = *(const u32x4*)(vb + kp + 16 * kk); } }
            while (t < 13) {
                int tn = t + 1; while (tn < 13 && !tile_ok(tn)) ++tn;
                u32x4 kn[4], vn[4];
                if (tn < 13) { const size_t kp = (size_t)tile_pos(tn) * 512;
#pragma unroll
                    for (int kk = 0; kk < 4; ++kk) { kn[kk] = *(const u32x4*)(kb + kp + 16 * kk); vn[kk] = *(const u32x4*)(vb + kp + 16 * kk); } }
#pragma unroll
                for (int kk = 0; kk < 4; ++kk) *(PG8_LAS u32x4*)(wsc + r * 144 + 32 * kk + 16 * h) = vc[kk];
                __builtin_amdgcn_wave_barrier();
                f32x16 s;
#pragma unroll
                for (int i = 0; i < 16; ++i) s[i] = 0.f;
#pragma unroll
                for (int kk = 0; kk < 4; ++kk) s = MFMA32(__builtin_bit_cast(bf16x8, kc[kk]), qf[kk], s);
                bf16x8 vv[2][2];
#pragma unroll
                for (int dt = 0; dt < 2; ++dt)
#pragma unroll
                    for (int sx = 0; sx < 2; ++sx) {
                        const s16x4 lo = __builtin_amdgcn_ds_read_tr16_b64_v4i16((PG8_LAS s16x4*)(wsc + (16 * sx + 4 * h + ((lane & 15) >> 2)) * 144 + (32 * dt + 16 * ((lane >> 4) & 1) + 4 * (lane & 3)) * 2));
                        const s16x4 hi = __builtin_amdgcn_ds_read_tr16_b64_v4i16((PG8_LAS s16x4*)(wsc + (16 * sx + 8 + 4 * h + ((lane & 15) >> 2)) * 144 + (32 * dt + 16 * ((lane >> 4) & 1) + 4 * (lane & 3)) * 2));
                        bf16x8 f; f[0] = lo[0]; f[1] = lo[1]; f[2] = lo[2]; f[3] = lo[3]; f[4] = hi[0]; f[5] = hi[1]; f[6] = hi[2]; f[7] = hi[3];
                        vv[dt][sx] = f; }
                __builtin_amdgcn_wave_barrier();
                const int base = (t < 8 ? 128 * a - 64 + 32 * t - (128 * a + (rr >> 2) + 4 * r) : 32 * a - 64 + 32 * (t - 8) - (32 * a + r)) + 4 * h;
#pragma unroll
                for (int i = 0; i < 16; ++i) { const int dd = base + 8 * (i >> 2) + (i & 3); s[i] = (dd <= 64 && dd >= -64) ? s[i] : -__builtin_inff(); }
                softmax_pv(s, o0, o1, m, l, vv[0][0], vv[0][1], vv[1][0], vv[1][1], lane, fresh);
#pragma unroll
                for (int kk = 0; kk < 4; ++kk) { kc[kk] = kn[kk]; vc[kk] = vn[kk]; }
                t = tn;
            }
        }
        attn_store(lane, o0, o1, l, O + ((size_t)b * 2048 + tq) * 1024 + 512 + head * 64 + 4 * h);
        __syncthreads();
    }
    __builtin_amdgcn_s_setprio(0);
}

__device__ __forceinline__ int clampi(int v, int lo, int hi) { return v < lo ? lo : (v > hi ? hi : v); }
__device__ __forceinline__ void na_phase(LASP lds, const bf16_t* __restrict__ QC, const bf16_t* __restrict__ KC, const bf16_t* __restrict__ VCT, const float* __restrict__ rpb, bf16_t* O, int tid) {
    typedef StageCfg<64> C;
    const int lane = tid & 63, w = tid >> 6, r = lane & 31, h = lane >> 5;
    PG8_LAS float* btab = (PG8_LAS float*)(lds + 5 * D64_SB + 256);
    if (__builtin_amdgcn_readfirstlane(tid >> 6) >= 4) __builtin_amdgcn_s_setprio(1);
    for (int it = blockIdx.x; it < 2048; it += gridDim.x) {
        int item = it;
        if (gridDim.x == 256) { const int k = it >> 8, B = it & 255, x = B & 7, y = B >> 3; item = ((((k * 8 + x) * 4) + (y >> 3)) << 3) | (y & 7); }
        const int bh = item >> 3, rg = item & 7, b = bh >> 4, head = bh & 15;
        const int rp = 2 * rg + (w >> 2), j = w & 3;
        const int qrow = 2 * rp + (r >> 4), qcol = 16 * j + (r & 15), tq = qrow * 64 + qcol;
        bf16x8 qf[4];
#pragma unroll
        for (int kk = 0; kk < 4; ++kk) qf[kk] = *(const bf16x8*)(QC + ((size_t)b * 2048 + tq) * 1024 + head * 64 + 16 * kk + 8 * h);
        const int rs_q = clampi(qrow - 4, 0, 24), cs_q = clampi(qcol - 8, 0, 48), band = clampi(16 * j - 8, 0, 32);
        const int kr_lo = clampi(4 * rg - 4, 0, 24), nst = clampi(4 * rg - 1, 0, 24) + 8 - kr_lo;
        const int wlo = clampi(2 * rp - 4, 0, 24), whi = clampi(2 * rp - 3, 0, 24) + 8;
        const int cbase = band + 4 * h - qcol + 15;
        float cadd[16];
#pragma unroll
        for (int i = 0; i < 16; ++i) { const int kc = band + 8 * (i >> 2) + 4 * h + (i & 3); cadd[i] = (kc >= cs_q && kc < cs_q + 16) ? 0.f : -__builtin_inff(); }
        const bf16_t* k0 = KC + ((size_t)b * 2048 + kr_lo * 64) * 1024 + head * 64;
        const bf16_t* vt0 = VCT + ((size_t)b * 2048 + kr_lo * 64) * 1024 + head * 64;
        f32x16 o0, o1;
#pragma unroll
        for (int i = 0; i < 16; ++i) { o0[i] = 0.f; o1[i] = 0.f; }
        float m = 0.f, l = 0.f; bool fresh = true;
        asm volatile("s_waitcnt lgkmcnt(0)" ::: "memory"); __builtin_amdgcn_s_barrier();
        btab[tid] = tid < 465 ? rpb[head * 465 + tid] * LOG2E : 0.f;
        if (tid < 16) btab[tid - 16] = 0.f;
        dma64_loop<5>(lds, 0, nst, k0, 1024, vt0, __builtin_amdgcn_readfirstlane(w), lane, [&](int st, LASP buf) {
            const int kr = kr_lo + st;
            if (kr >= wlo && kr < whi) {
                bf16x8 kf[4], v00, v01, v10, v11;
                d64_read(buf, band + r, lane, band, h, kf, v00, v01, v10, v11);
                f32x16 s;
#pragma unroll
                for (int i = 0; i < 16; ++i) s[i] = 0.f;
#pragma unroll
                for (int kk = 0; kk < 4; ++kk) s = MFMA32(kf[kk], qf[kk], s);
                const float radd = ((kr >= rs_q) && (kr < rs_q + 8)) ? 0.f : -__builtin_inff();
                const PG8_LAS float* bp = btab + clampi(kr - qrow + 7, 0, 14) * 31 + cbase;
#pragma unroll
                for (int i = 0; i < 16; ++i) s[i] = s[i] + (bp[8 * (i >> 2) + (i & 3)] + cadd[i]) + radd;
                softmax_pv(s, o0, o1, m, l, v00, v01, v10, v11, lane, fresh);
            }
        });
        attn_store(lane, o0, o1, l, O + ((size_t)b * 2048 + tq) * 1024 + head * 64 + 4 * h);
    }
    __builtin_amdgcn_s_setprio(0);
}

__device__ __forceinline__ int my_tid(int wid_s) { unsigned z = 0u; asm volatile("" : "+s"(z)); return wid_s * 64 + (int)__builtin_amdgcn_mbcnt_hi(~0u, __builtin_amdgcn_mbcnt_lo(~0u, z)); }
__global__ void __launch_bounds__(512, 2) fwd_kernel(Params p) {
    extern __shared__ __attribute__((aligned(16))) unsigned char shm[];
    cg::grid_group grid = cg::this_grid();
    PG8_LAS unsigned char* lds = (PG8_LAS unsigned char*)shm;
    const int tid = threadIdx.x, lane = tid & 63, wid = tid >> 6;
    const int wid_s = __builtin_amdgcn_readfirstlane(wid);
    const unsigned xcc = xb_xcc_id();
    if (tid < 4) ((volatile PG8_LAS unsigned*)(lds + pg8::STAGE_BYTES))[tid] = 0u;
    if (tid == 0) (void)xb_add((unsigned*)(p.ws + WS_BAR) + XB_XCNT(xcc), 1u);
    __syncthreads();
    const int gw = blockIdx.x * 8 + wid, nw = gridDim.x * 8;

    for (int rep0 = 0; rep0 < NREP(10); ++rep0)
    {
        unsigned char* ws = p.ws; float* cosA = (float*)(ws + WS_COSA); float* sinA = (float*)(ws + WS_SINA); float* cosB = (float*)(ws + WS_COSB); float* sinB = (float*)(ws + WS_SINB); bf16_t* XN = (bf16_t*)(ws + WS_XN);
        float* tl = (float*)shm;
        int rot = 0;
        for (int i = 0; i < 2; ++i) {
            prep_w(rot, tl, p.in[2] + (size_t)i * 1024 * 1952, 1952, 1024, p.in[1] + i * 1024, (bf16_t*)(ws + W_IN + i * SZ_IN), 1024, 0, 0, 2048, MAP_EVIN, 0);
            prep_w(rot, tl, p.in[4] + (size_t)i * 256 * 768, 768, 256, p.in[3] + i * 256, (bf16_t*)(ws + W_UP + i * SZ_UP), 384, 0, 0, 768, MAP_QUP, 0);
            prep_w(rot, tl, p.in[6] + (size_t)i * 128 * 1024, 1024, 128, p.in[5] + i * 128, (bf16_t*)(ws + W_UP + i * SZ_UP), 384, 256, 768, 1024, MAP_KVUP, 0);
            prep_w(rot, tl, p.in[7] + (size_t)i * 1024 * 1024, 1024, 1024, nullptr, (bf16_t*)(ws + W_EOUT + i * SZ_EOUT), 1024, 0, 0, 1024, MAP_P32, 0);
            prep_w(rot, tl, p.in[9] + (size_t)i * 1024 * 3072, 3072, 1024, p.in[8] + i * 1024, (bf16_t*)(ws + W_QKV + i * SZ_QKV), 1024, 0, 0, 3072, MAP_ODQKV, 0);
            prep_w(rot, tl, p.in[11] + (size_t)i * 1024 * 1024, 1024, 1024, nullptr, (bf16_t*)(ws + W_OOUT + i * SZ_OOUT), 1024, 0, 0, 1024, MAP_P32, 0);
        }
        for (int L = 0; L < 4; ++L) {
            prep_w(rot, tl, p.in[13] + (size_t)L * 1024 * 2816, 2816, 1024, p.in[12] + L * 1024, (bf16_t*)(ws + W_GU + L * SZ_GU), 1024, 0, 0, 5632, MAP_GU, 0);
            prep_w(rot, tl, p.in[14] + (size_t)L * 1024 * 2816, 2816, 1024, p.in[12] + L * 1024, (bf16_t*)(ws + W_GU + L * SZ_GU), 1024, 0, 0, 5632, MAP_GU, 1);
            prep_w(rot, tl, p.in[15] + (size_t)L * 2816 * 1024, 1024, 2816, nullptr, (bf16_t*)(ws + W_DN + L * SZ_DN), 2816, 0, 0, 1024, MAP_P32, 0);
        }
        for (int idx = blockIdx.x * 512 + tid; idx < 2048 * 32; idx += gridDim.x * 512) {
            const int pos = idx >> 5, i = idx & 31; const float inv = powf(10000.f, -(float)(2 * i) / 64.f), ang = (float)pos * inv;
            cosB[idx] = cosf(ang); sinB[idx] = sinf(ang);
            if (i < 16) { const float inva = powf(10000.f, -(float)(2 * i) / 32.f), anga = (float)pos * inva; cosA[pos * 16 + i] = cosf(anga); sinA[pos * 16 + i] = sinf(anga); }
        }
        float* nssq = (float*)(ws + WS_NSSQ);
        norm_phase(p.in[0], XN, nullptr, nullptr, nssq, gw, nw, lane);
    }
    grid.sync();

    for (int ph = 0; ph < 30 + EXTRA_N; ++ph) {
        const int lp = ph < 30 ? ph / 15 : 1, q = ph < 30 ? ph - 15 * lp : EXTRA_Q;
        __attribute__((address_space(1))) unsigned char* ws_g = (__attribute__((address_space(1))) unsigned char*)p.ws; asm volatile("" : "+s"(ws_g)); unsigned char* ws = (unsigned char*)ws_g;
        bf16_t* XN = (bf16_t*)(ws + WS_XN); bf16_t* O = (bf16_t*)(ws + WS_O); bf16_t* HFF = (bf16_t*)(ws + R_HFF);
        if (EN(0) && q == 0) {
            pg8::Gemm g{XN, (const bf16_t*)(ws + W_IN + lp * SZ_IN), T_, 2048, 1024};
            pg8::StaticOrder S; S.init(g.M, g.N, (int)gridDim.x, (int)blockIdx.x);
            EpiEvenIn E{ws, (const float*)(ws + WS_NSSQ)};
            pg8::gemm_phase<EpiEvenIn, pg8::StaticOrder, false>(lds, g, S, E, nullptr, my_tid(wid_s));
        } else if (EN(1) && q == 1) {
            pg8::Gemm g{(const bf16_t*)(ws + R_A2), (const bf16_t*)(ws + W_UP + lp * SZ_UP), T_, 1792, 384};
            pg8::StaticOrder S; S.init(g.M, g.N, (int)gridDim.x, (int)blockIdx.x);
            EpiEvenUp E{ws};
            pg8::gemm_phase<EpiEvenUp, pg8::StaticOrder, false>(lds, g, S, E, nullptr, my_tid(wid_s));
            dil_phase(lds, (const bf16_t*)(ws + R_QB), (const bf16_t*)(ws + R_KB), (const bf16_t*)(ws + R_VBT), (const bf16_t*)(ws + R_VB), O, my_tid(wid_s));
        } else if (EN(2) && q == 2) {
            const int t2 = my_tid(wid_s);
            { int nrep = NREP(8); asm volatile("" : "+s"(nrep)); for (int rep = 0; rep < nrep; ++rep)
                mla_phase(lds, (const bf16_t*)(ws + R_QA), (const bf16_t*)(ws + R_KA), (const bf16_t*)(ws + R_KPE), (const bf16_t*)(ws + R_VAT), O, t2); }
        } else if (EN(3) && (q == 3 || q == 6 || q == 10 || q == 13)) {
            const bool dn = (q == 6 || q == 13);
            const bf16_t* Bt = q == 3 ? (const bf16_t*)(ws + W_EOUT + lp * SZ_EOUT) : q == 10 ? (const bf16_t*)(ws + W_OOUT + lp * SZ_OOUT) : (const bf16_t*)(ws + W_DN + (2 * lp + (q == 13)) * SZ_DN);
            pg8::Gemm g{dn ? HFF : O, Bt, T_, 1024, dn ? 2816 : 1024};
            pg8::StaticOrder S; S.init(g.M, g.N, (int)gridDim.x, (int)blockIdx.x);
            EpiResid E{ph == 3 ? p.in[0] : nullptr, XN, (float*)(ws + WS_NSSQ)};
            pg8::gemm_phase<EpiResid, pg8::StaticOrder, false>(lds, g, S, E, nullptr, my_tid(wid_s));
        } else if (q == 4 || q == 7 || q == 11 || q == 14) {
            if (ph != 29) continue;
            const int t2 = my_tid(wid_s), lane = t2 & 63, gw = blockIdx.x * 8 + (t2 >> 6);
            final_norm_phase(XN, p.out, p.in[16], gw, nw, lane);
        } else if (EN(5) && (q == 5 || q == 12)) {
            pg8::Gemm g{XN, (const bf16_t*)(ws + W_GU + (2 * lp + (q == 12)) * SZ_GU), T_, 5632, 1024};
            pg8::StaticOrder S; S.init(g.M, g.N, (int)gridDim.x, (int)blockIdx.x);
            EpiGateUp E{HFF, (const float*)(ws + WS_NSSQ)};
            pg8::gemm_phase<EpiGateUp, pg8::StaticOrder, false>(lds, g, S, E, nullptr, my_tid(wid_s));
        } else if (EN(6) && q == 8) {
            pg8::Gemm g{XN, (const bf16_t*)(ws + W_QKV + lp * SZ_QKV), T_, 3072, 1024};
            pg8::StaticOrder S; S.init(g.M, g.N, (int)gridDim.x, (int)blockIdx.x);
            EpiOddQKV E{ws, (const float*)(ws + WS_NSSQ)};
            pg8::gemm_phase<EpiOddQKV, pg8::StaticOrder, false>(lds, g, S, E, nullptr, my_tid(wid_s));
        } else if (EN(7) && q == 9) {
            const int t2 = my_tid(wid_s);
            int nrep = NREP(7); asm volatile("" : "+s"(nrep));
            for (int rep = 0; rep < nrep; ++rep) na_phase(lds, (const bf16_t*)(ws + R_QC), (const bf16_t*)(ws + R_KC), (const bf16_t*)(ws + R_VCT), p.in[10] + (size_t)lp * 16 * 465, O, t2);
        }
        if (ph != 29 + EXTRA_N) { int nrep = NREP(11); asm volatile("" : "+s"(nrep)); for (int rep = 0; rep < nrep; ++rep) xcd_barrier((unsigned*)(ws + WS_BAR), xcc, (volatile PG8_LAS unsigned*)(lds + pg8::STAGE_BYTES), my_tid(wid_s)); }
    }
}

extern "C" void kernel_launch(void* const* d_in, const int* in_sizes, int n_in, void* d_out, int out_size, void* d_ws, size_t ws_size, hipStream_t stream) {
    constexpr int LDS_BYTES = pg8::STAGE_BYTES + 16;
    static int grid = 0;
    if (grid == 0) {
        if (n_in != 17 || out_size != T_ * 1024 || ws_size < WS_END) { fprintf(stderr, "kernel_launch: unexpected shapes (n_in %d out %d ws %zu, need %zu)\n", n_in, out_size, ws_size, (size_t)WS_END); grid = -1; return; }
        int dev = 0, cus = 0, per_cu = 0;
        hipGetDevice(&dev);
        hipDeviceGetAttribute(&cus, hipDeviceAttributeMultiprocessorCount, dev);
        if (hipFuncSetAttribute((const void*)fwd_kernel, hipFuncAttributeMaxDynamicSharedMemorySize, LDS_BYTES) != hipSuccess) { fprintf(stderr, "kernel_launch: hipFuncSetAttribute failed\n"); grid = -1; return; }
        if (hipOccupancyMaxActiveBlocksPerMultiprocessor(&per_cu, (const void*)fwd_kernel, 512, LDS_BYTES) != hipSuccess || per_cu < 1) { fprintf(stderr, "kernel_launch: occupancy query says %d\n", per_cu); per_cu = 1; }
        (void)hipGetLastError();
        grid = cus * 1;
    }
    if (grid < 0) return;
    if (hipMemsetAsync((char*)d_ws + WS_BAR, 0, XCD_BAR_WORDS * sizeof(unsigned), stream) != hipSuccess) { fprintf(stderr, "kernel_launch: memset of the barrier words failed\n"); return; }
    Params p{};
    for (int i = 0; i < 17; ++i) p.in[i] = (const float*)d_in[i];
    p.out = (float*)d_out; p.ws = (unsigned char*)d_ws;
    void* args[] = {&p};
    hipError_t e = hipLaunchCooperativeKernel((const void*)fwd_kernel, dim3(grid), dim3(512), args, LDS_BYTES, stream);
    if (e != hipSuccess) fprintf(stderr, "cooperative launch failed: %s (grid %d)\n", hipGetErrorString(e), grid);
}
```

```cpp
#include <hip/hip_runtime.h>
#include <hip/hip_cooperative_groups.h>
#include <cstdio>
#include <cstdint>
namespace cg = cooperative_groups;
namespace pg8 {
#define PG8_LAS __attribute__((address_space(3)))
typedef unsigned short bf16_t;
typedef short bf16x8 __attribute__((ext_vector_type(8)));
typedef float f32x4 __attribute__((ext_vector_type(4)));
typedef unsigned u32x4 __attribute__((ext_vector_type(4)));
constexpr int BM = 256, BK = 64, HALF = 128, HTB = HALF * BK * 2  , STAGE_BYTES = 8 * HTB, NXCD = 8, WGM = 8;

__host__ __device__ __forceinline__ int lds_byte(int r, int c) { const int st = (r >> 4) * 2 + (c >> 5), rr = r & 15, cc = c & 31, ob = rr * 64 + cc * 2; return st * 1024 + (ob ^ (((ob >> 9) & 1) << 5)); }
__host__ __device__ __forceinline__ void stage_rc(int b, int& R, int& C) { const int st = b / 1024, sb = b % 1024, swz = sb ^ (((sb >> 9) & 1) << 5); R = (st >> 1) * 16 + swz / 64; C = (st & 1) * 32 + (swz % 64) / 2; }
__host__ __device__ __forceinline__ int perm32(int rho) { const int n = rho >> 4, i = rho & 15; return 8 * (i >> 2) + 4 * n + (i & 3); }

struct Unit { int pm, pn; };
struct Gemm { const bf16_t* A; const bf16_t* Bt; int M, N, K; };

struct StaticOrder {
    int nM, nN, nwg, G, c;
    __host__ __device__ void init(int M, int N, int G_, int c_) { nM = M / BM; nN = N / BM; nwg = nM * nN; G = G_; c = c_; }
    __host__ __device__ bool next(int i, Unit& u) const {
        const long L = (long)i * G + c; if (L >= nwg) return false;
        int wgid = (int)L; { const int q = nwg / NXCD, r = nwg % NXCD, xcd = wgid % NXCD, off = wgid / NXCD; wgid = (xcd < r ? xcd * (q + 1) : r * (q + 1) + (xcd - r) * q) + off; }
        const int nig = WGM * nN, gid = wgid / nig, fm = gid * WGM, gsz = (nM - fm) < WGM ? (nM - fm) : WGM;
        u.pm = fm + ((wgid % nig) % gsz); u.pn = (wgid % nig) / gsz; return true;
    }
    __device__ __forceinline__ void a_ready(const Unit&) const {}
    __device__ __forceinline__ void done(const Unit&) const {}
};
template <class Epi, class Sched, bool STAMP = false>
__device__ __forceinline__ void gemm_phase(PG8_LAS unsigned char* lds, const Gemm g, const Sched& S, const Epi& E, unsigned long long* stamps, int tid_in) {
    int tid_l = tid_in; asm volatile("" : "+v"(tid_l));
    const int tid = tid_l, wid = __builtin_amdgcn_readfirstlane(tid >> 6), lane = tid & 63, wr = wid >> 2, wc = wid & 3, fr = lane & 15, fq = lane >> 4;
    const int K = g.K, nt = K / BK;
    int ts_lo = 0, ts_hi = 0, nts = 0; const unsigned long long rt_entry = STAMP ? (unsigned long long)wall_clock64() : 0ull;
#define PG8_STAMP() do { if (STAMP && wid == 0 && nts < 64) { const unsigned long long _c = (unsigned long long)clock64(); \
        ts_lo = (lane == nts) ? (int)(unsigned)_c : ts_lo; ts_hi = (lane == nts) ? (int)(unsigned)(_c >> 32) : ts_hi; ++nts; } } while (0)
    PG8_STAMP();
    unsigned voffA[2], voffB[2];
#pragma unroll
    for (int i = 0; i < 2; ++i) { int R, C; stage_rc(tid * 16 + i * 8192, R, C); const int Rb = Epi::PERM ? ((R & ~31) + perm32(R & 31)) : R;
        voffA[i] = (unsigned)(R * K + C) * 2u; voffB[i] = (unsigned)(Rb * K + C) * 2u; }
    const size_t kstep = (size_t)(BK * 2);
    const size_t hstep = (size_t)HALF * K * 2;
    const size_t tstep = 2 * hstep;
    const unsigned ldsw = (unsigned)wid * 1024u;
    const int aoff = lds_byte(wr * 64 + fr, fq * 8), boff = lds_byte(wc * 32 + fr, fq * 8);
#define PG8_SA(b, h) (((b) * 2 + (h)) * HTB)
#define PG8_SB(b, h) ((4 + (b) * 2 + (h)) * HTB)
#define PG8_STAGE(bufoff, gbase, voff) do { _Pragma("unroll") for (int _i = 0; _i < 2; ++_i) \
        __builtin_amdgcn_global_load_lds((const unsigned*)((const char*)(gbase) + (voff)[_i]), (PG8_LAS unsigned*)(lds + (bufoff) + ldsw + _i * 8192), 16, 0, 0); } while (0)
#define PG8_LDA(dst, b, h) do { _Pragma("unroll") for (int m = 0; m < 4; ++m) _Pragma("unroll") for (int k = 0; k < 2; ++k) dst[m][k] = *(const PG8_LAS bf16x8*)(lds + PG8_SA(b, h) + aoff + m * 2048 + k * 1024); } while (0)
#define PG8_LDB(dst, b, h) do { _Pragma("unroll") for (int n = 0; n < 2; ++n) _Pragma("unroll") for (int k = 0; k < 2; ++k) dst[n][k] = *(const PG8_LAS bf16x8*)(lds + PG8_SB(b, h) + boff + n * 2048 + k * 1024); } while (0)
#define PG8_MMA(ai, bj, At, Bt) do { __builtin_amdgcn_s_setprio(1); _Pragma("unroll") for (int m = 0; m < 4; ++m) _Pragma("unroll") for (int n = 0; n < 2; ++n) _Pragma("unroll") for (int k = 0; k < 2; ++k) \
        acc[ai][bj][m][n] = __builtin_amdgcn_mfma_f32_16x16x32_bf16(Bt[n][k], At[m][k], acc[ai][bj][m][n], 0, 0, 0); __builtin_amdgcn_s_setprio(0); } while (0)
#define PG8_WAIT_V(n) asm volatile("s_waitcnt vmcnt(" #n ")" ::: "memory")
#define PG8_WAIT_L(n) asm volatile("s_waitcnt lgkmcnt(" #n ")" ::: "memory")
#define PG8_BAR __builtin_amdgcn_s_barrier()
#define PG8_SCHED __builtin_amdgcn_sched_barrier(0)
    Unit cur, nxt; int ui = 0;
    if (!S.next(0, cur)) return;
    f32x4 acc[2][2][4][2];
#pragma unroll
    for (int a = 0; a < 2; ++a)
#pragma unroll
        for (int b = 0; b < 2; ++b)
#pragma unroll
            for (int m = 0; m < 4; ++m)
#pragma unroll
                for (int n = 0; n < 2; ++n) acc[a][b][m][n] = (f32x4){0.f, 0.f, 0.f, 0.f};
    bf16x8 At[4][2], B0[2][2], B1[2][2];
    const char* cA = (const char*)g.A + (size_t)cur.pm * tstep; const char* cB = (const char*)g.Bt + (size_t)cur.pn * tstep;
    S.a_ready(cur);
    PG8_STAGE(PG8_SB(0, 0), cB, voffB); PG8_STAGE(PG8_SA(0, 0), cA, voffA); PG8_STAGE(PG8_SB(0, 1), cB + hstep, voffB); PG8_STAGE(PG8_SA(0, 1), cA + hstep, voffA);
    if (wr == 1) PG8_BAR;
    PG8_WAIT_V(4); PG8_BAR;
    PG8_STAGE(PG8_SB(1, 0), cB + kstep, voffB); PG8_STAGE(PG8_SA(1, 0), cA + kstep, voffA); PG8_STAGE(PG8_SB(1, 1), cB + hstep + kstep, voffB);
    PG8_WAIT_V(6); PG8_BAR;
    PG8_STAMP();
    for (;;) {
        const bool has_next = S.next(ui + 1, nxt);
        const char* nA = has_next ? (const char*)g.A + (size_t)nxt.pm * tstep : cA; const char* nB = has_next ? (const char*)g.Bt + (size_t)nxt.pn * tstep : cB;
        for (int t = 0; t < nt; t += 2) {
            const bool last = (t == nt - 2);
            const char* a1 = cA + (size_t)(t + 1) * kstep;
            const char* a2 = last ? nA : cA + (size_t)(t + 2) * kstep; const char* b2 = last ? nB : cB + (size_t)(t + 2) * kstep;
            const char* a3 = a2 + kstep; const char* b3 = b2 + kstep;
            if (last && has_next) S.a_ready(nxt);
            PG8_LDB(B0, 0, 0); PG8_SCHED; PG8_LDA(At, 0, 0); PG8_STAGE(PG8_SA(1, 1), a1 + hstep, voffA);
            PG8_WAIT_L(8); PG8_BAR; PG8_WAIT_L(0); PG8_MMA(0, 0, At, B0); PG8_BAR; PG8_SCHED;
            PG8_LDB(B1, 0, 1); PG8_STAGE(PG8_SB(0, 0), b2, voffB);
            PG8_BAR; PG8_WAIT_L(0); PG8_MMA(0, 1, At, B1); PG8_BAR;
            PG8_LDA(At, 0, 1); PG8_STAGE(PG8_SA(0, 0), a2, voffA);
            PG8_BAR; PG8_WAIT_L(0); PG8_MMA(1, 0, At, B0); PG8_BAR; PG8_SCHED;
            PG8_STAGE(PG8_SB(0, 1), b2 + hstep, voffB);
            PG8_WAIT_V(6); PG8_BAR; PG8_MMA(1, 1, At, B1); PG8_BAR;
            PG8_LDB(B0, 1, 0); PG8_SCHED; PG8_LDA(At, 1, 0); PG8_STAGE(PG8_SA(0, 1), a2 + hstep, voffA);
            PG8_WAIT_L(8); PG8_BAR; PG8_WAIT_L(0); PG8_MMA(0, 0, At, B0); PG8_BAR; PG8_SCHED;
            PG8_LDB(B1, 1, 1); PG8_STAGE(PG8_SB(1, 0), b3, voffB);
            PG8_BAR; PG8_WAIT_L(0); PG8_MMA(0, 1, At, B1); PG8_BAR;
            PG8_LDA(At, 1, 1); PG8_STAGE(PG8_SA(1, 0), a3, voffA);
            PG8_BAR; PG8_WAIT_L(0); PG8_MMA(1, 0, At, B0); PG8_BAR; PG8_SCHED;
            PG8_STAGE(PG8_SB(1, 1), b3 + hstep, voffB);
            PG8_WAIT_V(6); PG8_BAR; PG8_MMA(1, 1, At, B1); PG8_BAR;
        }
        PG8_STAMP();
        if (wr == 0) PG8_BAR;
        if constexpr (!Epi::AFTER_DRAIN) { E(acc, cur, wr, wc, fr, fq); S.done(cur); }
        PG8_STAMP();
        if (!has_next) break;
#pragma unroll
        for (int a = 0; a < 2; ++a)
#pragma unroll
            for (int b = 0; b < 2; ++b)
#pragma unroll
                for (int m = 0; m < 4; ++m)
#pragma unroll
                    for (int n = 0; n < 2; ++n) acc[a][b][m][n] = (f32x4){0.f, 0.f, 0.f, 0.f};
        cur = nxt; cA = nA; cB = nB; ++ui;
        if (wr == 1) PG8_BAR;
    }
    PG8_WAIT_V(0);
    PG8_BAR;
    if constexpr (Epi::AFTER_DRAIN) { E.fused(acc, cur, wr, wc, fr, fq, lds, wid, lane); S.done(cur); }
    PG8_STAMP();
    if (STAMP && wid == 0) { stamps[lane] = lane < nts ? (((unsigned long long)(unsigned)ts_hi << 32) | (unsigned)ts_lo) : 0ull;
        if (lane == 62) stamps[62] = rt_entry; if (lane == 63) stamps[63] = (unsigned long long)wall_clock64(); }
#undef PG8_STAMP
#undef PG8_SA
#undef PG8_SB
#undef PG8_STAGE
#undef PG8_LDA
#undef PG8_LDB
#undef PG8_MMA
#undef PG8_WAIT_V
#undef PG8_WAIT_L
#undef PG8_BAR
#undef PG8_SCHED
}
}

using pg8::bf16_t;
using pg8::f32x4;
using pg8::u32x4;
using pg8::Unit;
typedef short bf16x8 __attribute__((ext_vector_type(8)));
typedef float f32x16 __attribute__((ext_vector_type(16)));
typedef unsigned u32x2 __attribute__((ext_vector_type(2)));
typedef short s16x4 __attribute__((ext_vector_type(4)));

#ifndef ENMASK
#define ENMASK 0xffff
#endif
#define EN(k) ((ENMASK >> (k)) & 1)
#ifndef REPMASK
#define REPMASK 0
#endif
#define NREP(k) (1 + ((REPMASK >> (k)) & 1))
#ifndef EXTRA_N
#define EXTRA_N 0
#endif
#ifndef EXTRA_Q
#define EXTRA_Q 5
#endif
constexpr int T_ = 32768, S_ = 2048;
constexpr float EPSV = 1e-6f;
constexpr float LOG2E = 1.4426950408889634f;
constexpr size_t MiB = (size_t)1 << 20;
constexpr size_t WS_COSA = 0, WS_SINA = 128 * 1024, WS_COSB = 256 * 1024, WS_SINB = 512 * 1024;
constexpr size_t WS_SSQ = 1 * MiB;
constexpr size_t WS_W = 2 * MiB;
constexpr size_t W_IN = WS_W, W_UP = WS_W + 8 * MiB, W_EOUT = WS_W + 11 * MiB, W_QKV = WS_W + 15 * MiB, W_OOUT = WS_W + 27 * MiB, W_GU = WS_W + 31 * MiB, W_DN = WS_W + 75 * MiB;
constexpr size_t SZ_IN = 4 * MiB, SZ_UP = 3 * MiB / 2, SZ_EOUT = 2 * MiB, SZ_QKV = 6 * MiB, SZ_OOUT = 2 * MiB, SZ_GU = 11 * MiB, SZ_DN = 11 * MiB / 2;
constexpr size_t WS_XN = 100 * MiB, WS_O = 164 * MiB, WS_R = 228 * MiB;
constexpr size_t R_QB = WS_R, R_KB = WS_R + 32 * MiB, R_VBT = WS_R + 64 * MiB, R_A2 = WS_R + 96 * MiB, R_KPE = WS_R + 120 * MiB, R_QA = WS_R + 122 * MiB, R_KA = WS_R + 170 * MiB, R_VAT = WS_R + 202 * MiB;
constexpr size_t R_QC = WS_R, R_KC = WS_R + 64 * MiB, R_VCT = WS_R + 128 * MiB;
constexpr size_t R_HFF = WS_R;
constexpr size_t R_VB = WS_R + 234 * MiB;
constexpr size_t WS_NSSQ = WS_R + 266 * MiB;
constexpr size_t WS_END = WS_NSSQ + 2 * MiB;
constexpr size_t WS_BAR = 896 * 1024;

struct Params {
    const float* in[17];
    float* out;
    unsigned char* ws;
};

__device__ __forceinline__ unsigned cvt_pk_bf16(float lo, float hi) { unsigned r; asm("v_cvt_pk_bf16_f32 %0, %1, %2" : "=v"(r) : "v"(lo), "v"(hi)); return r; }
__device__ __forceinline__ bf16_t f2bf(float f) { return (bf16_t)(cvt_pk_bf16(f, 0.f) & 0xffffu); }
__device__ __forceinline__ float xshfl(float v, int lane, int mask) { return __builtin_bit_cast(float, __builtin_amdgcn_ds_bpermute((lane ^ mask) << 2, __builtin_bit_cast(int, v))); }
__device__ __forceinline__ float fexp2(float x) { return __builtin_amdgcn_exp2f(x); }
__device__ __forceinline__ u32x2 pk4(f32x4 v) { u32x2 o; o.x = cvt_pk_bf16(v[0], v[1]); o.y = cvt_pk_bf16(v[2], v[3]); return o; }
__device__ __forceinline__ u32x4 pk8(f32x4 a, f32x4 b) { u32x4 o; o.x = cvt_pk_bf16(a[0], a[1]); o.y = cvt_pk_bf16(a[2], a[3]); o.z = cvt_pk_bf16(b[0], b[1]); o.w = cvt_pk_bf16(b[2], b[3]); return o; }


#define XB_TMO      128
#define XB_XCNT(j)  (256  + 64 * (j))
#define XB_XSUB(j)  (1280 + 64 * (j))
#define XB_XGEN(j)  (2304 + 64 * (j))
#define XB_TOP      3328
#define XB_TOPGEN   3392
#define XCD_BAR_WORDS 3456
#define XB_SPIN_CAP (1u << 20)
__device__ __forceinline__ unsigned xb_ld(unsigned* p)              { return __hip_atomic_load(p, __ATOMIC_RELAXED, __HIP_MEMORY_SCOPE_AGENT); }
__device__ __forceinline__ unsigned xb_add(unsigned* p, unsigned v) { return __hip_atomic_fetch_add(p, v, __ATOMIC_RELAXED, __HIP_MEMORY_SCOPE_AGENT); }
__device__ __forceinline__ unsigned xb_xcc_id() { return (unsigned)__builtin_amdgcn_s_getreg((3 << 11) | 20) & 0xFu; }
#define XB_SPIN(cond, bar) do { unsigned _sp = 0; while (cond) { __builtin_amdgcn_s_sleep(1); \
    if ((++_sp & 255u) == 0u) { if (xb_ld(&(bar)[XB_TMO])) break; if (_sp > XB_SPIN_CAP) { atomicAdd(&(bar)[XB_TMO], 1u); break; } } } } while (0)
__device__ __forceinline__ void xcd_barrier_complete(unsigned* bar, unsigned x, unsigned& nloc, unsigned& nx) {
    const unsigned G = gridDim.x;
    unsigned sum, cnt, mine, sp = 0u;
    for (;;) {
        sum = 0u; cnt = 0u; mine = 0u;
#pragma unroll
        for (unsigned j = 0; j < 16; ++j) { const unsigned c = xb_ld(&bar[XB_XCNT(j)]); sum += c; cnt += (c > 0u) ? 1u : 0u; mine = (j == x) ? c : mine; }
        if (sum == G) break;
        __builtin_amdgcn_s_sleep(1);
        if ((++sp & 255u) == 0u) { if (xb_ld(&bar[XB_TMO])) break; if (sp > XB_SPIN_CAP) { atomicAdd(&bar[XB_TMO], 1u); break; } }
    }
    nloc = mine > 0u ? mine : 1u; nx = cnt > 0u ? cnt : 1u;
}
__device__ __forceinline__ void xcd_barrier(unsigned* bar, unsigned x, volatile PG8_LAS unsigned* st, int tid) {
    asm volatile("s_waitcnt vmcnt(0)" ::: "memory");
    __syncthreads();
    if (tid == 0) {
        __builtin_amdgcn_s_waitcnt(0);
        unsigned nloc = st[0], nx = st[1];
        if (nloc == 0u) { xcd_barrier_complete(bar, x, nloc, nx); st[0] = nloc; st[1] = nx; }
        const unsigned old = xb_add(&bar[XB_XSUB(x)], 1u);
        const unsigned gen = old / nloc;
        if (old + 1u == (gen + 1u) * nloc) {
            __builtin_amdgcn_fence(__ATOMIC_RELEASE, "agent");
            asm volatile("s_waitcnt vmcnt(0)" ::: "memory");
            const unsigned og = xb_add(&bar[XB_TOP], 1u);
            const unsigned tg = og / nx;
            if (og + 1u == (tg + 1u) * nx) xb_add(&bar[XB_TOPGEN], 1u);
            else XB_SPIN(xb_ld(&bar[XB_TOPGEN]) == tg, bar);
            __builtin_amdgcn_fence(__ATOMIC_ACQUIRE, "agent");
            xb_add(&bar[XB_XGEN(x)], 1u);
            asm volatile("s_waitcnt vmcnt(0)" ::: "memory");
        } else {
            XB_SPIN(xb_ld(&bar[XB_XGEN(x)]) == gen, bar);
            __builtin_amdgcn_fence(__ATOMIC_ACQUIRE, "agent");
            asm volatile("s_waitcnt vmcnt(0)" ::: "memory");
        }
    }
    __syncthreads();
}

__device__ __forceinline__ void row_rs8(const float* __restrict__ nssq, int row0, int fr, int fq, float (&rs)[2][4]) {
    f32x4 part[2][4];
#pragma unroll
    for (int ai = 0; ai < 2; ++ai)
#pragma unroll
        for (int m = 0; m < 4; ++m) part[ai][m] = *(const f32x4*)(nssq + (size_t)(row0 + ai * 128 + m * 16) * 16 + 4 * fq);
#pragma unroll
    for (int ai = 0; ai < 2; ++ai)
#pragma unroll
        for (int m = 0; m < 4; ++m) { float s = part[ai][m][0] + part[ai][m][1] + part[ai][m][2] + part[ai][m][3];
            s += xshfl(s, fr + 16 * fq, 16); s += xshfl(s, fr + 16 * fq, 32);
            rs[ai][m] = rsqrtf(s * (1.f / 1024.f) + EPSV); }
}
struct EpiResid {
    static constexpr bool PERM = false, AFTER_DRAIN = false;
    const float* x0; bf16_t* xn; float* nssq;
    __device__ __forceinline__ void operator()(const f32x4 (&acc)[2][2][4][2], const Unit& u, int wr, int wc, int fr, int fq) const {
        asm volatile("" : "+v"(fr), "+v"(fq));
        const int row0 = u.pm * 256 + wr * 64 + fr, col0 = u.pn * 256 + wc * 32 + 8 * fq;
        float ssv[2][4];
#pragma unroll
        for (int ai = 0; ai < 2; ++ai) {
            f32x4 hv[4][2][2];
            if (x0) {
#pragma unroll
                for (int m = 0; m < 4; ++m)
#pragma unroll
                    for (int bj = 0; bj < 2; ++bj)
#pragma unroll
                        for (int n = 0; n < 2; ++n) hv[m][bj][n] = *(const f32x4*)(x0 + (size_t)(row0 + ai * 128 + m * 16) * 1024 + col0 + bj * 128 + n * 4);
            } else {
                u32x4 hb[4][2];
#pragma unroll
                for (int m = 0; m < 4; ++m)
#pragma unroll
                    for (int bj = 0; bj < 2; ++bj) hb[m][bj] = *(const u32x4*)(xn + (size_t)(row0 + ai * 128 + m * 16) * 1024 + col0 + bj * 128);
#pragma unroll
                for (int m = 0; m < 4; ++m)
#pragma unroll
                    for (int bj = 0; bj < 2; ++bj) { const u32x4 t = hb[m][bj]; f32x4 v0, v1;
                        v0[0] = __uint_as_float(t.x << 16); v0[1] = __uint_as_float(t.x & 0xffff0000u); v0[2] = __uint_as_float(t.y << 16); v0[3] = __uint_as_float(t.y & 0xffff0000u);
                        v1[0] = __uint_as_float(t.z << 16); v1[1] = __uint_as_float(t.z & 0xffff0000u); v1[2] = __uint_as_float(t.w << 16); v1[3] = __uint_as_float(t.w & 0xffff0000u);
                        hv[m][bj][0] = v0; hv[m][bj][1] = v1; }
            }
#pragma unroll
            for (int m = 0; m < 4; ++m) { const int row = row0 + ai * 128 + m * 16; float ss = 0.f;
#pragma unroll
                for (int bj = 0; bj < 2; ++bj) { const u32x4 pk = pk8(hv[m][bj][0] + acc[ai][bj][m][0], hv[m][bj][1] + acc[ai][bj][m][1]);
                    *(u32x4*)(xn + (size_t)row * 1024 + col0 + bj * 128) = pk;
                    const float r0 = __uint_as_float(pk.x << 16), r1 = __uint_as_float(pk.x & 0xffff0000u), r2 = __uint_as_float(pk.y << 16), r3 = __uint_as_float(pk.y & 0xffff0000u);
                    const float r4 = __uint_as_float(pk.z << 16), r5 = __uint_as_float(pk.z & 0xffff0000u), r6 = __uint_as_float(pk.w << 16), r7 = __uint_as_float(pk.w & 0xffff0000u);
                    ss += r0 * r0 + r1 * r1 + r2 * r2 + r3 * r3 + r4 * r4 + r5 * r5 + r6 * r6 + r7 * r7; }
                ss += xshfl(ss, fr + 16 * fq, 16); ss += xshfl(ss, fr + 16 * fq, 32);
                ssv[ai][m] = ss; }
            __builtin_amdgcn_sched_barrier(0);
        }
#pragma unroll
        for (int ai = 0; ai < 2; ++ai) { const float v = fq == 0 ? ssv[ai][0] : fq == 1 ? ssv[ai][1] : fq == 2 ? ssv[ai][2] : ssv[ai][3];
            nssq[(size_t)(row0 + ai * 128 + fq * 16) * 16 + 4 * u.pn + wc] = v; }
    }
};
struct EpiGateUp {
    static constexpr bool PERM = false, AFTER_DRAIN = false;
    bf16_t* hff; const float* nssq;
    __device__ __forceinline__ void operator()(const f32x4 (&acc)[2][2][4][2], const Unit& u, int wr, int wc, int fr, int fq) const {
        asm volatile("" : "+v"(fr), "+v"(fq));
        const int row0 = u.pm * 256 + wr * 64 + fr, fcol = u.pn * 128 + wc * 32 + 8 * fq;
        float rs8[2][4]; row_rs8(nssq, row0, fr, fq, rs8);
#pragma unroll
        for (int ai = 0; ai < 2; ++ai)
#pragma unroll
            for (int m = 0; m < 4; ++m) {
                const float rs = rs8[ai][m];
                f32x4 r0, r1;
#pragma unroll
                for (int j = 0; j < 4; ++j) {
                    const float g0 = acc[ai][0][m][0][j] * rs, g1 = acc[ai][0][m][1][j] * rs;
                    r0[j] = g0 * __builtin_amdgcn_rcpf(1.f + fexp2(-g0 * LOG2E)) * (acc[ai][1][m][0][j] * rs);
                    r1[j] = g1 * __builtin_amdgcn_rcpf(1.f + fexp2(-g1 * LOG2E)) * (acc[ai][1][m][1][j] * rs);
                }
                *(u32x4*)(hff + (size_t)(row0 + ai * 128 + m * 16) * 2816 + fcol) = pk8(r0, r1);
            }
    }
};
struct EpiEvenIn {
    static constexpr bool PERM = false, AFTER_DRAIN = false;
    unsigned char* ws; const float* nssq;
    __device__ __forceinline__ void operator()(const f32x4 (&acc)[2][2][4][2], const Unit& u, int wr, int wc, int fr, int fq) const {
        asm volatile("" : "+v"(fr), "+v"(fq));
        bf16_t* const qb = (bf16_t*)(ws + R_QB); bf16_t* const kb = (bf16_t*)(ws + R_KB); bf16_t* const vbt = (bf16_t*)(ws + R_VBT); bf16_t* const a2 = (bf16_t*)(ws + R_A2); bf16_t* const kpe = (bf16_t*)(ws + R_KPE);
        float* const ssq = (float*)(ws + WS_SSQ); const float* const cosA = (const float*)(ws + WS_COSA); const float* const sinA = (const float*)(ws + WS_SINA); const float* const cosB = (const float*)(ws + WS_COSB); const float* const sinB = (const float*)(ws + WS_SINB);
        const int row0 = u.pm * 256 + wr * 64 + fr, pn = u.pn;
        float rs8[2][4]; row_rs8(nssq, row0, fr, fq, rs8);
        if (pn < 4) {
            bf16_t* dst = pn < 2 ? qb : kb; const float sc = pn < 2 ? 0.125f * LOG2E : 1.f;
            const int hcol = (4 * (pn & 1) + wc) * 64 + 8 * fq;
#pragma unroll
            for (int ai = 0; ai < 2; ++ai) {
                f32x4 cc[4][2], sn[4][2];
#pragma unroll
                for (int m = 0; m < 4; ++m)
#pragma unroll
                    for (int n = 0; n < 2; ++n) { const int pos = (row0 + ai * 128 + m * 16) & 2047; cc[m][n] = *(const f32x4*)(cosB + pos * 32 + 8 * fq + 4 * n); sn[m][n] = *(const f32x4*)(sinB + pos * 32 + 8 * fq + 4 * n); }
#pragma unroll
                for (int m = 0; m < 4; ++m) { const int row = row0 + ai * 128 + m * 16; const float rsc = rs8[ai][m] * sc;
                    f32x4 o1[2], o2[2];
#pragma unroll
                    for (int n = 0; n < 2; ++n) { const f32x4 x1 = acc[ai][0][m][n], x2 = acc[ai][1][m][n];
                        o1[n] = (x1 * cc[m][n] - x2 * sn[m][n]) * rsc; o2[n] = (x2 * cc[m][n] + x1 * sn[m][n]) * rsc; }
                    bf16_t* p = dst + (size_t)row * 512 + hcol;
                    *(u32x4*)p = pk8(o1[0], o1[1]); *(u32x4*)(p + 32) = pk8(o2[0], o2[1]); }
                __builtin_amdgcn_sched_barrier(0);
            }
        } else if (pn < 6) {
            bf16_t* const vb = (bf16_t*)(ws + R_VB);
#pragma unroll
            for (int ai = 0; ai < 2; ++ai)
#pragma unroll
                for (int m = 0; m < 4; ++m) { const int row = row0 + ai * 128 + m * 16, pos = row & 2047, b = row >> 11; const float rs = rs8[ai][m];
#pragma unroll
                    for (int bj = 0; bj < 2; ++bj) { const int f0 = (pn - 4) * 256 + bj * 128 + wc * 32 + 8 * fq;
                        const f32x4 y0 = acc[ai][bj][m][0] * rs, y1 = acc[ai][bj][m][1] * rs;
                        *(u32x4*)(vb + (size_t)row * 512 + f0) = pk8(y0, y1);
                    }
                    __builtin_amdgcn_sched_barrier(0); }
        } else if (pn == 6) {
            float ssv[2][4];
#pragma unroll
            for (int ai = 0; ai < 2; ++ai)
#pragma unroll
                for (int m = 0; m < 4; ++m) { const int row = row0 + ai * 128 + m * 16; float ss = 0.f; const float rs = rs8[ai][m];
#pragma unroll
                    for (int bj = 0; bj < 2; ++bj) { const f32x4 v0 = acc[ai][bj][m][0] * rs, v1 = acc[ai][bj][m][1] * rs;
#pragma unroll
                        for (int j = 0; j < 4; ++j) ss += v0[j] * v0[j] + v1[j] * v1[j];
                        *(u32x4*)(a2 + (size_t)row * 384 + bj * 128 + wc * 32 + 8 * fq) = pk8(v0, v1); }
                    ss += xshfl(ss, fr + 16 * fq, 16); ss += xshfl(ss, fr + 16 * fq, 32);
                    ssv[ai][m] = ss; }
#pragma unroll
            for (int ai = 0; ai < 2; ++ai) ssq[(size_t)(row0 + ai * 128 + fq * 16) * 8 + wc] = fq == 0 ? ssv[ai][0] : fq == 1 ? ssv[ai][1] : fq == 2 ? ssv[ai][2] : ssv[ai][3];
        } else {
            float ssv[2][4];
#pragma unroll
            for (int ai = 0; ai < 2; ++ai) {
                f32x4 cc[4], sn[4];
                if (wc == 0) {
#pragma unroll
                    for (int m = 0; m < 4; ++m) { const int pos = (row0 + ai * 128 + m * 16) & 2047; cc[m] = *(const f32x4*)(cosA + pos * 16 + 4 * fq); sn[m] = *(const f32x4*)(sinA + pos * 16 + 4 * fq); }
                }
#pragma unroll
                for (int m = 0; m < 4; ++m) { const int row = row0 + ai * 128 + m * 16; float ss = 0.f; const float rs = rs8[ai][m];
                    { const f32x4 v0 = acc[ai][0][m][0] * rs, v1 = acc[ai][0][m][1] * rs;
#pragma unroll
                      for (int j = 0; j < 4; ++j) ss += v0[j] * v0[j] + v1[j] * v1[j];
                      *(u32x4*)(a2 + (size_t)row * 384 + 256 + wc * 32 + 8 * fq) = pk8(v0, v1); }
                    ss += xshfl(ss, fr + 16 * fq, 16); ss += xshfl(ss, fr + 16 * fq, 32);
                    ssv[ai][m] = ss;
                    if (wc == 0) { const f32x4 x1 = acc[ai][1][m][0] * rs, x2 = acc[ai][1][m][1] * rs;
                        bf16_t* p = kpe + (size_t)row * 32 + 4 * fq;
                        *(u32x2*)p = pk4(x1 * cc[m] - x2 * sn[m]); *(u32x2*)(p + 16) = pk4(x2 * cc[m] + x1 * sn[m]); } }
                __builtin_amdgcn_sched_barrier(0);
            }
#pragma unroll
            for (int ai = 0; ai < 2; ++ai) ssq[(size_t)(row0 + ai * 128 + fq * 16) * 8 + 4 + wc] = fq == 0 ? ssv[ai][0] : fq == 1 ? ssv[ai][1] : fq == 2 ? ssv[ai][2] : ssv[ai][3];
        }
    }
};
struct EpiEvenUp {
    static constexpr bool PERM = false, AFTER_DRAIN = false;
    unsigned char* ws;
    __device__ __forceinline__ void operator()(const f32x4 (&acc)[2][2][4][2], const Unit& u, int wr, int wc, int fr, int fq) const {
        asm volatile("" : "+v"(fr), "+v"(fq));
        bf16_t* const qa = (bf16_t*)(ws + R_QA); bf16_t* const ka = (bf16_t*)(ws + R_KA); bf16_t* const vat = (bf16_t*)(ws + R_VAT);
        const float* const ssq = (const float*)(ws + WS_SSQ); const float* const cosA = (const float*)(ws + WS_COSA); const float* const sinA = (const float*)(ws + WS_SINA);
        const int row0 = u.pm * 256 + wr * 64 + fr, pn = u.pn;
        float rs8[2][4];
        { f32x4 q[2][4];
#pragma unroll
          for (int ai = 0; ai < 2; ++ai)
#pragma unroll
              for (int m = 0; m < 4; ++m) q[ai][m] = *(const f32x4*)(ssq + (size_t)(row0 + ai * 128 + m * 16) * 8 + (pn < 3 ? 0 : 4));
          const float dinv = pn < 3 ? (1.f / 256.f) : (1.f / 128.f), mul = pn < 3 ? (0.10206207261596575f * LOG2E) : 1.f;
#pragma unroll
          for (int ai = 0; ai < 2; ++ai)
#pragma unroll
              for (int m = 0; m < 4; ++m) rs8[ai][m] = rsqrtf((q[ai][m][0] + q[ai][m][1] + q[ai][m][2] + q[ai][m][3]) * dinv + EPSV) * mul; }
        if (pn < 3) {
            int hoff[2], part[2];
#pragma unroll
            for (int bj = 0; bj < 2; ++bj) { const int G = 8 * pn + 4 * bj + wc, head = G / 3; part[bj] = G - 3 * head; hoff[bj] = head * 96 + (part[bj] < 2 ? 32 * part[bj] + 8 * fq : 64 + 4 * fq); }
            const bool anyrope = (part[0] == 2) || (part[1] == 2);
#pragma unroll
            for (int ai = 0; ai < 2; ++ai) {
                f32x4 cc[4], sn[4];
                if (anyrope) {
#pragma unroll
                    for (int m = 0; m < 4; ++m) { const int pos = (row0 + ai * 128 + m * 16) & 2047; cc[m] = *(const f32x4*)(cosA + pos * 16 + 4 * fq); sn[m] = *(const f32x4*)(sinA + pos * 16 + 4 * fq); }
                }
#pragma unroll
                for (int m = 0; m < 4; ++m) { const int row = row0 + ai * 128 + m * 16; const float rs = rs8[ai][m];
#pragma unroll
                    for (int bj = 0; bj < 2; ++bj) {
                        const f32x4 x1 = acc[ai][bj][m][0] * rs, x2 = acc[ai][bj][m][1] * rs;
                        bf16_t* p = qa + (size_t)row * 768 + hoff[bj];
                        if (part[bj] < 2) *(u32x4*)p = pk8(x1, x2);
                        else { *(u32x2*)p = pk4(x1 * cc[m] - x2 * sn[m]); *(u32x2*)(p + 16) = pk4(x2 * cc[m] + x1 * sn[m]); } } }
                __builtin_amdgcn_sched_barrier(0);
            }
        } else {
            int head[2], part[2];
#pragma unroll
            for (int bj = 0; bj < 2; ++bj) { const int G = 8 * (pn - 3) + 4 * bj + wc; head[bj] = G >> 2; part[bj] = G & 3; }
#pragma unroll
            for (int ai = 0; ai < 2; ++ai)
#pragma unroll
                for (int m = 0; m < 4; ++m) { const int row = row0 + ai * 128 + m * 16, pos = row & 2047, b = row >> 11; const float rs = rs8[ai][m];
#pragma unroll
                    for (int bj = 0; bj < 2; ++bj) {
                        const f32x4 x1 = acc[ai][bj][m][0] * rs, x2 = acc[ai][bj][m][1] * rs;
                        if (part[bj] < 2) *(u32x4*)(ka + (size_t)row * 512 + head[bj] * 64 + 32 * part[bj] + 8 * fq) = pk8(x1, x2);
                        else *(u32x4*)(vat + (size_t)row * 512 + head[bj] * 64 + 32 * (part[bj] - 2) + 8 * fq) = pk8(x1, x2); }
                    __builtin_amdgcn_sched_barrier(0); }
        }
    }
};
struct EpiOddQKV {
    static constexpr bool PERM = false, AFTER_DRAIN = false;
    unsigned char* ws; const float* nssq;
    __device__ __forceinline__ void operator()(const f32x4 (&acc)[2][2][4][2], const Unit& u, int wr, int wc, int fr, int fq) const {
        asm volatile("" : "+v"(fr), "+v"(fq));
        bf16_t* const qc = (bf16_t*)(ws + R_QC); bf16_t* const kc = (bf16_t*)(ws + R_KC); bf16_t* const vct = (bf16_t*)(ws + R_VCT);
        const int row0 = u.pm * 256 + wr * 64 + fr, pn = u.pn;
        float rs8[2][4]; row_rs8(nssq, row0, fr, fq, rs8);
        if (pn < 8) {
            bf16_t* dst = pn < 4 ? qc : kc; const float sc = pn < 4 ? 0.125f * LOG2E : 1.f;
#pragma unroll
            for (int ai = 0; ai < 2; ++ai)
#pragma unroll
                for (int m = 0; m < 4; ++m) { const int row = row0 + ai * 128 + m * 16; const float rsc = rs8[ai][m] * sc;
#pragma unroll
                    for (int bj = 0; bj < 2; ++bj)
                        *(u32x4*)(dst + (size_t)row * 1024 + (pn & 3) * 256 + bj * 128 + wc * 32 + 8 * fq) = pk8(acc[ai][bj][m][0] * rsc, acc[ai][bj][m][1] * rsc); }
        } else {
#pragma unroll
            for (int ai = 0; ai < 2; ++ai)
#pragma unroll
                for (int m = 0; m < 4; ++m) { const int row = row0 + ai * 128 + m * 16; const float rs = rs8[ai][m];
#pragma unroll
                    for (int bj = 0; bj < 2; ++bj)
                        *(u32x4*)(vct + (size_t)row * 1024 + (pn - 8) * 256 + bj * 128 + wc * 32 + 8 * fq) = pk8(acc[ai][bj][m][0] * rs, acc[ai][bj][m][1] * rs); }
        }
    }
};

enum { MAP_IDENT = 0, MAP_EVIN, MAP_QUP, MAP_KVUP, MAP_ODQKV, MAP_GU, MAP_P32 };
__device__ __forceinline__ int p32(int w) { return (w & ~31) + pg8::perm32(w & 31); }
__device__ __forceinline__ int src_col(int map, int c, int sel) {
    switch (map) {
    case MAP_EVIN: { const int pn = c >> 8, w = c & 255;
        if (pn < 4) { const int bj = w >> 7, wc = (w >> 5) & 3, d = pg8::perm32(w & 31) + 32 * bj, head = 4 * (pn & 1) + wc; return 416 + (pn >> 1) * 512 + head * 64 + d; }
        if (pn < 6) return 416 + 1024 + (pn - 4) * 256 + p32(w);
        if (pn == 6) return p32(w);
        if (w < 128) return 256 + p32(w);
        if (w < 160) return 384 + (w - 128);
        return -1; }
    case MAP_QUP: { const int G = c >> 5, head = G / 3, part = G - 3 * head, rho = c & 31; return part < 2 ? head * 96 + 32 * part + pg8::perm32(rho) : head * 96 + 64 + rho; }
    case MAP_KVUP: { const int G = c >> 5, head = G >> 2, part = G & 3, rho = c & 31; return head * 128 + 32 * part + pg8::perm32(rho); }
    case MAP_ODQKV: { const int which = c >> 10, f = c & 1023; return which * 1024 + p32(f); }
    case MAP_GU: { const int pn = c >> 8, bj = (c >> 7) & 1, w = c & 127; if (bj != sel) return -2; return 128 * pn + p32(w); }
    case MAP_P32: return p32(c);
    default: return c;
    }
}
__device__ __forceinline__ void prep_w(float* tl, const float* __restrict__ W, int Nsrc, int Ksrc, const float* __restrict__ gain, bf16_t* Bt, int Kt, int klo, int row0, int nrows, int map, int sel) {
    const int tid = threadIdx.x, nkt = Kt >> 7, ntile = (nrows >> 6) * nkt;
    for (int t = blockIdx.x; t < ntile; t += gridDim.x) {
        const int tr = t / nkt, tk = t - tr * nkt;
        if (map == MAP_GU && src_col(map, tr * 64, sel) == -2) continue;
        { const int c = tid & 63, kq = tid >> 6, src = src_col(map, tr * 64 + c, sel);
          float v[16];
#pragma unroll
          for (int i = 0; i < 16; ++i) { const int ks = tk * 128 + kq * 16 + i - klo; v[i] = 0.f;
              if (src >= 0 && ks >= 0 && ks < Ksrc) v[i] = W[(size_t)ks * Nsrc + src]; }
          if (gain) {
#pragma unroll
              for (int i = 0; i < 16; ++i) { const int ks = tk * 128 + kq * 16 + i - klo; if (src >= 0 && ks >= 0 && ks < Ksrc) v[i] *= gain[ks]; } }
#pragma unroll
          for (int i = 0; i < 16; ++i) tl[(kq * 16 + i) * 65 + c] = v[i]; }
        __syncthreads();
#pragma unroll
        for (int half = 0; half < 2; ++half) { const int kc = tid & 15, c = (tid >> 4) + 32 * half; float v[8];
#pragma unroll
          for (int i = 0; i < 8; ++i) v[i] = tl[(kc * 8 + i) * 65 + c];
          u32x4 o; o.x = cvt_pk_bf16(v[0], v[1]); o.y = cvt_pk_bf16(v[2], v[3]); o.z = cvt_pk_bf16(v[4], v[5]); o.w = cvt_pk_bf16(v[6], v[7]);
          *(u32x4*)(Bt + (size_t)(row0 + tr * 64 + c) * Kt + tk * 128 + kc * 8) = o; }
        __syncthreads();
    }
}

__device__ __forceinline__ void norm_phase(const float* __restrict__ h, bf16_t* xn, float* outf, const float* __restrict__ g, float* ssq_out, int gw, int nw, int lane) {
    for (int row = gw; row < T_; row += nw) {
        const f32x4* p = (const f32x4*)(h + (size_t)row * 1024);
        f32x4 v[4]; float ss = 0.f;
#pragma unroll
        for (int i = 0; i < 4; ++i) { v[i] = p[lane + 64 * i]; ss += v[i][0] * v[i][0] + v[i][1] * v[i][1] + v[i][2] * v[i][2] + v[i][3] * v[i][3]; }
#pragma unroll
        for (int o = 32; o >= 1; o >>= 1) ss += xshfl(ss, lane, o);
        const float rs = rsqrtf(ss * (1.f / 1024.f) + EPSV);
        if (outf) {
#pragma unroll
            for (int i = 0; i < 4; ++i) { const f32x4 gg = *(const f32x4*)(g + 4 * (lane + 64 * i)); *(f32x4*)(outf + (size_t)row * 1024 + 4 * (lane + 64 * i)) = v[i] * rs * gg; }
        } else {
#pragma unroll
            for (int i = 0; i < 4; ++i) *(u32x2*)(xn + (size_t)row * 1024 + 4 * (lane + 64 * i)) = pk4(v[i]);
            if (lane < 16) ssq_out[row * 16 + lane] = lane == 0 ? ss : 0.f;
        }
    }
}

__device__ __forceinline__ void final_norm_phase(const bf16_t* __restrict__ xn, float* outf, const float* __restrict__ g, int gw, int nw, int lane) {
    for (int row = gw; row < T_; row += nw) {
        const u32x4* p = (const u32x4*)(xn + (size_t)row * 1024);
        f32x4 v[4]; float ss = 0.f;
#pragma unroll
        for (int i = 0; i < 2; ++i) { const u32x4 t = p[lane + 64 * i];
            v[2 * i][0] = __uint_as_float(t.x << 16); v[2 * i][1] = __uint_as_float(t.x & 0xffff0000u); v[2 * i][2] = __uint_as_float(t.y << 16); v[2 * i][3] = __uint_as_float(t.y & 0xffff0000u);
            v[2 * i + 1][0] = __uint_as_float(t.z << 16); v[2 * i + 1][1] = __uint_as_float(t.z & 0xffff0000u); v[2 * i + 1][2] = __uint_as_float(t.w << 16); v[2 * i + 1][3] = __uint_as_float(t.w & 0xffff0000u); }
#pragma unroll
        for (int i = 0; i < 4; ++i) ss += v[i][0] * v[i][0] + v[i][1] * v[i][1] + v[i][2] * v[i][2] + v[i][3] * v[i][3];
#pragma unroll
        for (int o = 32; o >= 1; o >>= 1) ss += xshfl(ss, lane, o);
        const float rs = rsqrtf(ss * (1.f / 1024.f) + EPSV);
#pragma unroll
        for (int i = 0; i < 2; ++i) { const int c0 = 8 * (lane + 64 * i);
            *(f32x4*)(outf + (size_t)row * 1024 + c0) = v[2 * i] * rs * *(const f32x4*)(g + c0);
            *(f32x4*)(outf + (size_t)row * 1024 + c0 + 4) = v[2 * i + 1] * rs * *(const f32x4*)(g + c0 + 4); }
    }
}

#define MFMA32(a, b, c) __builtin_amdgcn_mfma_f32_32x32x16_bf16(a, b, c, 0, 0, 0)
__device__ __forceinline__ bf16x8 mk8(u32x2 a, u32x2 b) { u32x4 t; t.x = a.x; t.y = a.y; t.z = b.x; t.w = b.y; return __builtin_bit_cast(bf16x8, t); }
typedef float f32x8v __attribute__((ext_vector_type(8)));
typedef float f32x2v __attribute__((ext_vector_type(2)));
__device__ __forceinline__ void softmax_pv(const f32x16& s, f32x16& o0, f32x16& o1, float& m, float& l, const bf16x8 v00, const bf16x8 v01, const bf16x8 v10, const bf16x8 v11, int lane, bool& fresh) {
    if (fresh) {
        float mx = s[0];
#pragma unroll
        for (int i = 1; i < 16; ++i) mx = fmaxf(mx, s[i]);
        mx = fmaxf(mx, xshfl(mx, lane, 32));
        m = fmaxf(mx, -16.f);
        fresh = false;
    }
    const f32x16 t = s - m;
    f32x16 p;
#pragma unroll
    for (int i = 0; i < 16; ++i) p[i] = fexp2(t[i]);
    const f32x8v a8 = p.lo + p.hi; const f32x4 a4 = a8.lo + a8.hi; const f32x2v a2 = a4.lo + a4.hi;
    l += a2.x + a2.y;
    u32x4 a, b;
    a.x = cvt_pk_bf16(p[0], p[1]); a.y = cvt_pk_bf16(p[2], p[3]); a.z = cvt_pk_bf16(p[4], p[5]); a.w = cvt_pk_bf16(p[6], p[7]);
    b.x = cvt_pk_bf16(p[8], p[9]); b.y = cvt_pk_bf16(p[10], p[11]); b.z = cvt_pk_bf16(p[12], p[13]); b.w = cvt_pk_bf16(p[14], p[15]);
    const bf16x8 pk0 = __builtin_bit_cast(bf16x8, a), pk1 = __builtin_bit_cast(bf16x8, b);
    o0 = MFMA32(v00, pk0, o0); o0 = MFMA32(v01, pk1, o0);
    o1 = MFMA32(v10, pk0, o1); o1 = MFMA32(v11, pk1, o1);
}
__device__ __forceinline__ void attn_store(int lane, const f32x16& o0, const f32x16& o1, float l, bf16_t* op  ) {
    const float inv = 1.f / (l + xshfl(l, lane, 32));
#pragma unroll
    for (int g = 0; g < 4; ++g) {
        u32x2 a, b;
        a.x = cvt_pk_bf16(o0[4 * g] * inv, o0[4 * g + 1] * inv); a.y = cvt_pk_bf16(o0[4 * g + 2] * inv, o0[4 * g + 3] * inv);
        b.x = cvt_pk_bf16(o1[4 * g] * inv, o1[4 * g + 1] * inv); b.y = cvt_pk_bf16(o1[4 * g + 2] * inv, o1[4 * g + 3] * inv);
        *(u32x2*)(op + 8 * g) = a; *(u32x2*)(op + 32 + 8 * g) = b;
    }
}
__device__ __forceinline__ void load_vt(const bf16_t* vrow, bf16x8& v00, bf16x8& v01, bf16x8& v10, bf16x8& v11) {
    v00 = mk8(*(const u32x2*)(vrow), *(const u32x2*)(vrow + 8)); v01 = mk8(*(const u32x2*)(vrow + 16), *(const u32x2*)(vrow + 24));
    const bf16_t* v1 = vrow + 32 * 2048;
    v10 = mk8(*(const u32x2*)(v1), *(const u32x2*)(v1 + 8)); v11 = mk8(*(const u32x2*)(v1 + 16), *(const u32x2*)(v1 + 24));
}

#define LASP PG8_LAS unsigned char*
__device__ __forceinline__ void read_vtr(LASP vimg, int keyoff, int lane, bf16x8& v00, bf16x8& v01, bf16x8& v10, bf16x8& v11) {
    LASP base = vimg + (keyoff + 4 * (lane >> 5) + ((lane & 15) >> 2)) * 144 + (16 * ((lane >> 4) & 1) + 4 * (lane & 3)) * 2;
    bf16x8 f[2][2];
#pragma unroll
    for (int dt = 0; dt < 2; ++dt)
#pragma unroll
        for (int s = 0; s < 2; ++s) {
            const s16x4 lo = __builtin_amdgcn_ds_read_tr16_b64_v4i16((PG8_LAS s16x4*)(base + (16 * s) * 144 + 64 * dt));
            const s16x4 hi = __builtin_amdgcn_ds_read_tr16_b64_v4i16((PG8_LAS s16x4*)(base + (16 * s + 8) * 144 + 64 * dt));
            bf16x8 g; g[0] = lo[0]; g[1] = lo[1]; g[2] = lo[2]; g[3] = lo[3]; g[4] = hi[0]; g[5] = hi[1]; g[6] = hi[2]; g[7] = hi[3]; f[dt][s] = g; }
    v00 = f[0][0]; v01 = f[0][1]; v10 = f[1][0]; v11 = f[1][1];
}
template <int KD> struct StageCfg { static constexpr int KP = KD * 2 + 16, KBYTES = 64 * KP, VP = 136, VBYTES = 64 * VP, BYTES = KBYTES + VBYTES; };
struct StageRegs { u32x4 k, v, pe; };
template <int KD>
__device__ __forceinline__ void stage_issue(StageRegs& R, const bf16_t* __restrict__ krow0, int kstride, const bf16_t* __restrict__ pe0, const bf16_t* __restrict__ vt0, int tid) {
    R.k = *(const u32x4*)(krow0 + (size_t)(tid >> 3) * kstride + (tid & 7) * 8);
    R.v = *(const u32x4*)(vt0 + (size_t)(tid >> 3) * 2048 + (tid & 7) * 8);
    if (KD == 96) R.pe = *(const u32x4*)(pe0 + ((tid >> 2) & 63) * 32 + (tid & 3) * 8);
}
template <int KD>
__device__ __forceinline__ void stage_commit(LASP buf, const StageRegs& R, int tid) {
    typedef StageCfg<KD> C;
    *(PG8_LAS u32x4*)(buf + (tid >> 3) * C::KP + (tid & 7) * 16) = R.k;
    LASP vp = buf + C::KBYTES + (tid >> 3) * C::VP + (tid & 7) * 16;
    u32x2 a, b; a.x = R.v.x; a.y = R.v.y; b.x = R.v.z; b.y = R.v.w;
    *(PG8_LAS u32x2*)vp = a; *(PG8_LAS u32x2*)(vp + 8) = b;
    if (KD == 96) { if (tid < 256) *(PG8_LAS u32x4*)(buf + (tid >> 2) * C::KP + 128 + (tid & 3) * 16) = R.pe; }
}
template <int KD>
__device__ __forceinline__ void read_kf(LASP buf, int row, int h, bf16x8 (&kf)[KD / 16]) {
#pragma unroll
    for (int kk = 0; kk < KD / 16; ++kk) kf[kk] = *(const PG8_LAS bf16x8*)(buf + row * StageCfg<KD>::KP + 32 * kk + 16 * h);
}
__device__ __forceinline__ void read_vf(LASP vbuf, int r, int keyoff, bf16x8& v00, bf16x8& v01, bf16x8& v10, bf16x8& v11) {
    LASP p0 = vbuf + r * 136 + keyoff * 2; LASP p1 = p0 + 32 * 136;
    v00 = mk8(*(const PG8_LAS u32x2*)(p0), *(const PG8_LAS u32x2*)(p0 + 16)); v01 = mk8(*(const PG8_LAS u32x2*)(p0 + 32), *(const PG8_LAS u32x2*)(p0 + 48));
    v10 = mk8(*(const PG8_LAS u32x2*)(p1), *(const PG8_LAS u32x2*)(p1 + 16)); v11 = mk8(*(const PG8_LAS u32x2*)(p1 + 32), *(const PG8_LAS u32x2*)(p1 + 48));
}


template <int KD, int PD, bool ALWAYS, class Src, class Comp>
__device__ __forceinline__ void staged_loop(LASP lds, int s_lo, int s_hi, int tid, Src&& src, Comp&& comp) {
    typedef StageCfg<KD> C;
    if (s_lo >= s_hi) return;
    StageRegs R[PD];
    src(s_lo, R[0]); stage_commit<KD>(lds + (s_lo & 1) * C::BYTES, R[0], tid);
#pragma unroll
    for (int d = 1; d < PD; ++d) { if (ALWAYS) src(s_lo + d < s_hi ? s_lo + d : s_hi - 1, R[d]); else if (s_lo + d < s_hi) src(s_lo + d, R[d]); }
    __syncthreads();
    for (int st = s_lo; st < s_hi; st += PD) {
#pragma unroll
        for (int d = 0; d < PD; ++d) {
            const int s = st + d;
            if (s < s_hi) {
                if (ALWAYS) src(s + PD < s_hi ? s + PD : s_hi - 1, R[d]); else if (s + PD < s_hi) src(s + PD, R[d]);
                comp(s, lds + (s & 1) * C::BYTES);
                if (s + 1 < s_hi) stage_commit<KD>(lds + ((s + 1) & 1) * C::BYTES, R[(d + 1) % PD], tid);
                __syncthreads();
            }
        }
    }
}

__device__ __forceinline__ void mla_phase(LASP lds, const bf16_t* __restrict__ QA, const bf16_t* __restrict__ KA, const bf16_t* __restrict__ KPE, const bf16_t* __restrict__ VAT, bf16_t* O, int tid) {
    constexpr int KB_ = 64 * 208, SB = KB_ + 64 * 144 + 2 * 1024;
    const int lane = tid & 63, w = __builtin_amdgcn_readfirstlane(tid >> 6), r = lane & 31, h = lane >> 5;
    if (w >= 4) __builtin_amdgcn_s_setprio(1);
    for (int it = blockIdx.x; it < 1024; it += gridDim.x) {
        int item = it;
        if (gridDim.x == 256) { const int k = it >> 8, B = it & 255, x = B & 7, y = B >> 3; item = ((((k * 8 + x) * 4) + (y >> 3)) << 3) | (y & 7); }
        const int bh = item >> 3, qb8 = item & 7, b = bh >> 3, head = bh & 7;
        const size_t tq = (size_t)b * 2048 + qb8 * 256 + w * 32 + r;
        bf16x8 qf[6];
#pragma unroll
        for (int kk = 0; kk < 6; ++kk) qf[kk] = *(const bf16x8*)(QA + tq * 768 + head * 96 + 16 * kk + 8 * h);
        const char* src[3]; unsigned step[3]; int dst[3];
#pragma unroll
        for (int j = 0; j < 3; ++j) {
            const int p = w + 8 * j;
            if (p < 13) { const int c = 64 * p + lane, row = c / 13, col = c - 13 * row;
                if (col >= 8 && col < 12) { src[j] = (const char*)(KPE + ((size_t)b * 2048 + row) * 32 + (col - 8) * 8); step[j] = 64 * 32 * 2; }
                else { src[j] = (const char*)(KA + ((size_t)b * 2048 + row) * 512 + head * 64 + (col & 7) * 8); step[j] = 64 * 512 * 2; }
                dst[j] = p * 1024; }
            else if (p < 22) { const int c = 64 * (p - 13) + lane, row = c / 9, col = c - 9 * row;
                src[j] = (const char*)(VAT + ((size_t)b * 2048 + row) * 512 + head * 64 + (col & 7) * 8); step[j] = 64 * 512 * 2; dst[j] = KB_ + (p - 13) * 1024; }
            else { src[j] = (const char*)(KA + ((size_t)b * 2048 + lane) * 512); step[j] = 0; dst[j] = KB_ + 64 * 144 + (p - 22) * 1024; }
        }
        f32x16 o0, o1;
#pragma unroll
        for (int i = 0; i < 16; ++i) { o0[i] = 0.f; o1[i] = 0.f; }
        float m = 0.f, l = 0.f; bool fresh = true;
#define MLA_ISSUE(st) do { const int _s = (st) < 32 ? (st) : 31; LASP _b = lds + ((st) % 5) * SB; _Pragma("unroll") for (int _j = 0; _j < 3; ++_j) \
        __builtin_amdgcn_global_load_lds((const unsigned*)(src[_j] + (size_t)_s * step[_j]), (PG8_LAS unsigned*)(_b + dst[_j]), 16, 0, 0); } while (0)
        asm volatile("s_waitcnt vmcnt(0) lgkmcnt(0)" ::: "memory"); __builtin_amdgcn_s_barrier();
        MLA_ISSUE(0); MLA_ISSUE(1); MLA_ISSUE(2); MLA_ISSUE(3);
        for (int st = 0; st < 32; ++st) {
            asm volatile("s_waitcnt vmcnt(9)" ::: "memory");
            __builtin_amdgcn_s_barrier();
            asm volatile("" ::: "memory");
            MLA_ISSUE(st + 4);
            LASP buf = lds + (st % 5) * SB;
#pragma unroll
            for (int sub = 0; sub < 2; ++sub) {
                bf16x8 kf[6], v00, v01, v10, v11;
#pragma unroll
                for (int kk = 0; kk < 6; ++kk) kf[kk] = *(const PG8_LAS bf16x8*)(buf + (32 * sub + r) * 208 + 32 * kk + 16 * h);
                read_vtr(buf + KB_, 32 * sub, lane, v00, v01, v10, v11);
                __builtin_amdgcn_sched_barrier(0);
                f32x16 s;
#pragma unroll
                for (int i = 0; i < 16; ++i) s[i] = 0.f;
#pragma unroll
                for (int kk = 0; kk < 6; ++kk) s = MFMA32(kf[kk], qf[kk], s);
                softmax_pv(s, o0, o1, m, l, v00, v01, v10, v11, lane, fresh);
            }
        }
#undef MLA_ISSUE
        attn_store(lane, o0, o1, l, O + tq * 1024 + head * 64 + 4 * h);
    }
    __builtin_amdgcn_s_setprio(0);
    asm volatile("s_waitcnt vmcnt(0)" ::: "memory"); __syncthreads();
}


constexpr int D64_KB = 64 * 144, D64_SB = 2 * D64_KB + 1024;
template <int NBUF, class Comp>
__device__ __forceinline__ void dma64_loop(LASP lds, int s_lo, int s_hi, const bf16_t* kbase  , int kstride, const bf16_t* vbase  , int w, int lane, Comp&& comp) {
    const char* src[3]; unsigned step[3]; int dst[3];
#pragma unroll
    for (int j = 0; j < 3; ++j) {
        const int p = w + 8 * j;
        if (p < 9) { const int c = 64 * p + lane, row = c / 9, col = c - 9 * row; src[j] = (const char*)(kbase + (size_t)row * kstride + (col & 7) * 8); step[j] = (unsigned)(64 * kstride * 2); dst[j] = p * 1024; }
        else if (p < 18) { const int c = 64 * (p - 9) + lane, row = c / 9, col = c - 9 * row; src[j] = (const char*)(vbase + (size_t)row * kstride + (col & 7) * 8); step[j] = (unsigned)(64 * kstride * 2); dst[j] = D64_KB + (p - 9) * 1024; }
        else { src[j] = (const char*)(kbase + (size_t)lane * kstride); step[j] = 0u; dst[j] = 2 * D64_KB; }
    }
#define D64_ISSUE(st) do { const int _s = (st) < s_hi ? (st) : s_hi - 1; LASP _b = lds + (((st) - s_lo) % NBUF) * D64_SB; _Pragma("unroll") for (int _j = 0; _j < 3; ++_j) \
        __builtin_amdgcn_global_load_lds((const unsigned*)(src[_j] + (size_t)_s * step[_j]), (PG8_LAS unsigned*)(_b + dst[_j]), 16, 0, 0); } while (0)
    asm volatile("s_waitcnt vmcnt(0) lgkmcnt(0)" ::: "memory"); __builtin_amdgcn_s_barrier();
#pragma unroll
    for (int d = 0; d < NBUF - 1; ++d) D64_ISSUE(s_lo + d);
    for (int st = s_lo; st < s_hi; ++st) {
        if (NBUF == 5) asm volatile("s_waitcnt vmcnt(9)" ::: "memory"); else if (NBUF == 4) asm volatile("s_waitcnt vmcnt(6)" ::: "memory"); else asm volatile("s_waitcnt vmcnt(3)" ::: "memory");
        __builtin_amdgcn_s_barrier();
        asm volatile("" ::: "memory");
        D64_ISSUE(st + NBUF - 1);
        comp(st, lds + ((st - s_lo) % NBUF) * D64_SB);
    }
#undef D64_ISSUE
    asm volatile("s_waitcnt vmcnt(0)" ::: "memory"); __builtin_amdgcn_s_barrier();
}
__device__ __forceinline__ void d64_read(LASP buf, int krow, int lane, int keyoff, int h, bf16x8 (&kf)[4], bf16x8& v00, bf16x8& v01, bf16x8& v10, bf16x8& v11) {
#pragma unroll
    for (int kk = 0; kk < 4; ++kk) kf[kk] = *(const PG8_LAS bf16x8*)(buf + krow * 144 + 32 * kk + 16 * h);
    read_vtr(buf + D64_KB, keyoff, lane, v00, v01, v10, v11);
}

__device__ __forceinline__ void dil_phase(LASP lds, const bf16_t* __restrict__ QB, const bf16_t* __restrict__ KB, const bf16_t* __restrict__ VBT, const bf16_t* __restrict__ VB, bf16_t* O, int tid) {
    typedef StageCfg<64> C;
    const int lane = tid & 63, w = tid >> 6, r = lane & 31, h = lane >> 5;
    LASP wsc = lds + 4 * D64_SB + w * 4608;
    if (__builtin_amdgcn_readfirstlane(tid >> 6) >= 4) __builtin_amdgcn_s_setprio(1);
    for (int it = blockIdx.x; it < 1024; it += gridDim.x) {
        int item = it;
        if (gridDim.x == 256) { const int k = it >> 8, B = it & 255, x = B & 7, y = B >> 3; item = ((((k * 8 + x) * 4) + (y >> 3)) << 3) | (y & 7); }
        const int bh = item >> 3, a = (item >> 1) & 3, rr = 8 * (item & 1) + w, b = bh >> 3, head = bh & 7;
        const int tq = 512 * a + rr + 16 * r;
        bf16x8 qf[4];
#pragma unroll
        for (int kk = 0; kk < 4; ++kk) qf[kk] = *(const bf16x8*)(QB + ((size_t)b * 2048 + tq) * 512 + head * 64 + 16 * kk + 8 * h);
        f32x16 o0, o1;
#pragma unroll
        for (int i = 0; i < 16; ++i) { o0[i] = 0.f; o1[i] = 0.f; }
        float m = 0.f, l = 0.f; bool fresh = true;
        {
            const int s_lo = a == 0 ? 1 : 0, s_hi = a == 3 ? 9 : 10;
            const bf16_t* k0 = KB + ((size_t)b * 2048 + 512 * a - 64) * 512 + head * 64;
            const bf16_t* vt0 = VB + ((size_t)b * 2048 + 512 * a - 64) * 512 + head * 64;
            dma64_loop<4>(lds, s_lo, s_hi, k0, 512, vt0, __builtin_amdgcn_readfirstlane(w), lane, [&](int st, LASP buf) {
#pragma unroll
                for (int sub = 0; sub < 2; ++sub) {
                    bf16x8 kf[4], v00, v01, v10, v11;
                    d64_read(buf, 32 * sub + r, lane, 32 * sub, h, kf, v00, v01, v10, v11);
                    f32x16 s;
#pragma unroll
                    for (int i = 0; i < 16; ++i) s[i] = 0.f;
#pragma unroll
                    for (int kk = 0; kk < 4; ++kk) s = MFMA32(kf[kk], qf[kk], s);
                    const int base = 512 * a - 64 + 64 * st + 32 * sub + 4 * h - tq;
#pragma unroll
                    for (int i = 0; i < 16; ++i) { const int dd = base + 8 * (i >> 2) + (i & 3); s[i] = (dd <= 64 && dd >= -64) ? s[i] : -__builtin_inff(); }
                    softmax_pv(s, o0, o1, m, l, v00, v01, v10, v11, lane, fresh);
                }
            });
        }
        {
            const bf16_t* kb = KB + (size_t)b * 2048 * 512 + head * 64 + 8 * h;
            const bf16_t* vb = VB + (size_t)b * 2048 * 512 + head * 64 + 8 * h;
            auto tile_ok = [&](int t) -> bool { const int u0 = t < 8 ? 128 * a - 64 + 32 * t : 32 * a - 64 + 32 * (t - 8); return u0 >= 0 && u0 < (t < 8 ? 512 : 128); };
            auto tile_pos = [&](int t) -> int { return t < 8 ? 4 * (128 * a - 64 + 32 * t + r) + (rr & 3) : 16 * (32 * a - 64 + 32 * (t - 8) + r) + rr; };
            int t = 0; while (t < 13 && !tile_ok(t)) ++t;
            u32x4 kc[4], vc[4];
            if (t < 13) { const size_t kp = (size_t)tile_pos(t) * 512;
#pragma unroll
                for (int kk = 0; kk < 4; ++kk) { kc[kk] = *(const u32x4*)(kb + kp + 16 * kk); vc[kk] = *(const u32x4*)(vb + kp + 16 * kk); } }
            while (t < 13) {
                int tn = t + 1; while (tn < 13 && !tile_ok(tn)) ++tn;
                u32x4 kn[4], vn[4];
                if (tn < 13) { const size_t kp = (size_t)tile_pos(tn) * 512;
#pragma unroll
                    for (int kk = 0; kk < 4; ++kk) { kn[kk] = *(const u32x4*)(kb + kp + 16 * kk); vn[kk] = *(const u32x4*)(vb + kp + 16 * kk); } }
#pragma unroll
                for (int kk = 0; kk < 4; ++kk) *(PG8_LAS u32x4*)(wsc + r * 144 + 32 * kk + 16 * h) = vc[kk];
                __builtin_amdgcn_wave_barrier();
                f32x16 s;
#pragma unroll
                for (int i = 0; i < 16; ++i) s[i] = 0.f;
#pragma unroll
                for (int kk = 0; kk < 4; ++kk) s = MFMA32(__builtin_bit_cast(bf16x8, kc[kk]), qf[kk], s);
                bf16x8 vv[2][2];
#pragma unroll
                for (int dt = 0; dt < 2; ++dt)
#pragma unroll
                    for (int sx = 0; sx < 2; ++sx) {
                        const s16x4 lo = __builtin_amdgcn_ds_read_tr16_b64_v4i16((PG8_LAS s16x4*)(wsc + (16 * sx + 4 * h + ((lane & 15) >> 2)) * 144 + (32 * dt + 16 * ((lane >> 4) & 1) + 4 * (lane & 3)) * 2));
                        const s16x4 hi = __builtin_amdgcn_ds_read_tr16_b64_v4i16((PG8_LAS s16x4*)(wsc + (16 * sx + 8 + 4 * h + ((lane & 15) >> 2)) * 144 + (32 * dt + 16 * ((lane >> 4) & 1) + 4 * (lane & 3)) * 2));
                        bf16x8 f; f[0] = lo[0]; f[1] = lo[1]; f[2] = lo[2]; f[3] = lo[3]; f[4] = hi[0]; f[5] = hi[1]; f[6] = hi[2]; f[7] = hi[3];
                        vv[dt][sx] = f; }
                __builtin_amdgcn_wave_barrier();
                const int base = (t < 8 ? 128 * a - 64 + 32 * t - (128 * a + (rr >> 2) + 4 * r) : 32 * a - 64 + 32 * (t - 8) - (32 * a + r)) + 4 * h;
#pragma unroll
                for (int i = 0; i < 16; ++i) { const int dd = base + 8 * (i >> 2) + (i & 3); s[i] = (dd <= 64 && dd >= -64) ? s[i] : -__builtin_inff(); }
                softmax_pv(s, o0, o1, m, l, vv[0][0], vv[0][1], vv[1][0], vv[1][1], lane, fresh);
#pragma unroll
                for (int kk = 0; kk < 4; ++kk) { kc[kk] = kn[kk]; vc[kk] = vn[kk]; }
                t = tn;
            }
        }
        attn_store(lane, o0, o1, l, O + ((size_t)b * 2048 + tq) * 1024 + 512 + head * 64 + 4 * h);
        __syncthreads();
    }
    __builtin_amdgcn_s_setprio(0);
}

__device__ __forceinline__ int clampi(int v, int lo, int hi) { return v < lo ? lo : (v > hi ? hi : v); }
__device__ __forceinline__ void na_phase(LASP lds, const bf16_t* __restrict__ QC, const bf16_t* __restrict__ KC, const bf16_t* __restrict__ VCT, const float* __restrict__ rpb, bf16_t* O, int tid) {
    typedef StageCfg<64> C;
    const int lane = tid & 63, w = tid >> 6, r = lane & 31, h = lane >> 5;
    PG8_LAS float* btab = (PG8_LAS float*)(lds + 5 * D64_SB + 256);
    if (__builtin_amdgcn_readfirstlane(tid >> 6) >= 4) __builtin_amdgcn_s_setprio(1);
    for (int it = blockIdx.x; it < 2048; it += gridDim.x) {
        int item = it;
        if (gridDim.x == 256) { const int k = it >> 8, B = it & 255, x = B & 7, y = B >> 3; item = ((((k * 8 + x) * 4) + (y >> 3)) << 3) | (y & 7); }
        const int bh = item >> 3, rg = item & 7, b = bh >> 4, head = bh & 15;
        const int rp = 2 * rg + (w >> 2), j = w & 3;
        const int qrow = 2 * rp + (r >> 4), qcol = 16 * j + (r & 15), tq = qrow * 64 + qcol;
        bf16x8 qf[4];
#pragma unroll
        for (int kk = 0; kk < 4; ++kk) qf[kk] = *(const bf16x8*)(QC + ((size_t)b * 2048 + tq) * 1024 + head * 64 + 16 * kk + 8 * h);
        const int rs_q = clampi(qrow - 4, 0, 24), cs_q = clampi(qcol - 8, 0, 48), band = clampi(16 * j - 8, 0, 32);
        const int kr_lo = clampi(4 * rg - 4, 0, 24), nst = clampi(4 * rg - 1, 0, 24) + 8 - kr_lo;
        const int wlo = clampi(2 * rp - 4, 0, 24), whi = clampi(2 * rp - 3, 0, 24) + 8;
        const int cbase = band + 4 * h - qcol + 15;
        float cadd[16];
#pragma unroll
        for (int i = 0; i < 16; ++i) { const int kc = band + 8 * (i >> 2) + 4 * h + (i & 3); cadd[i] = (kc >= cs_q && kc < cs_q + 16) ? 0.f : -__builtin_inff(); }
        const bf16_t* k0 = KC + ((size_t)b * 2048 + kr_lo * 64) * 1024 + head * 64;
        const bf16_t* vt0 = VCT + ((size_t)b * 2048 + kr_lo * 64) * 1024 + head * 64;
        f32x16 o0, o1;
#pragma unroll
        for (int i = 0; i < 16; ++i) { o0[i] = 0.f; o1[i] = 0.f; }
        float m = 0.f, l = 0.f; bool fresh = true;
        asm volatile("s_waitcnt lgkmcnt(0)" ::: "memory"); __builtin_amdgcn_s_barrier();
        btab[tid] = tid < 465 ? rpb[head * 465 + tid] * LOG2E : 0.f;
        if (tid < 16) btab[tid - 16] = 0.f;
        dma64_loop<5>(lds, 0, nst, k0, 1024, vt0, __builtin_amdgcn_readfirstlane(w), lane, [&](int st, LASP buf) {
            const int kr = kr_lo + st;
            if (kr >= wlo && kr < whi) {
                bf16x8 kf[4], v00, v01, v10, v11;
                d64_read(buf, band + r, lane, band, h, kf, v00, v01, v10, v11);
                f32x16 s;
#pragma unroll
                for (int i = 0; i < 16; ++i) s[i] = 0.f;
#pragma unroll
                for (int kk = 0; kk < 4; ++kk) s = MFMA32(kf[kk], qf[kk], s);
                const float radd = ((kr >= rs_q) && (kr < rs_q + 8)) ? 0.f : -__builtin_inff();
                const PG8_LAS float* bp = btab + clampi(kr - qrow + 7, 0, 14) * 31 + cbase;
#pragma unroll
                for (int i = 0; i < 16; ++i) s[i] = s[i] + (bp[8 * (i >> 2) + (i & 3)] + cadd[i]) + radd;
                softmax_pv(s, o0, o1, m, l, v00, v01, v10, v11, lane, fresh);
            }
        });
        attn_store(lane, o0, o1, l, O + ((size_t)b * 2048 + tq) * 1024 + head * 64 + 4 * h);
    }
    __builtin_amdgcn_s_setprio(0);
}

__device__ __forceinline__ int my_tid(int wid_s) { unsigned z = 0u; asm volatile("" : "+s"(z)); return wid_s * 64 + (int)__builtin_amdgcn_mbcnt_hi(~0u, __builtin_amdgcn_mbcnt_lo(~0u, z)); }
__global__ void __launch_bounds__(512, 2) fwd_kernel(Params p) {
    extern __shared__ __attribute__((aligned(16))) unsigned char shm[];
    cg::grid_group grid = cg::this_grid();
    PG8_LAS unsigned char* lds = (PG8_LAS unsigned char*)shm;
    const int tid = threadIdx.x, lane = tid & 63, wid = tid >> 6;
    const int wid_s = __builtin_amdgcn_readfirstlane(wid);
    const unsigned xcc = xb_xcc_id();
    if (tid < 4) ((volatile PG8_LAS unsigned*)(lds + pg8::STAGE_BYTES))[tid] = 0u;
    if (tid == 0) (void)xb_add((unsigned*)(p.ws + WS_BAR) + XB_XCNT(xcc), 1u);
    __syncthreads();
    const int gw = blockIdx.x * 8 + wid, nw = gridDim.x * 8;

    for (int rep0 = 0; rep0 < NREP(10); ++rep0)
    {
        unsigned char* ws = p.ws; float* cosA = (float*)(ws + WS_COSA); float* sinA = (float*)(ws + WS_SINA); float* cosB = (float*)(ws + WS_COSB); float* sinB = (float*)(ws + WS_SINB); bf16_t* XN = (bf16_t*)(ws + WS_XN);
        float* tl = (float*)shm;
        for (int i = 0; i < 2; ++i) {
            prep_w(tl, p.in[2] + (size_t)i * 1024 * 1952, 1952, 1024, p.in[1] + i * 1024, (bf16_t*)(ws + W_IN + i * SZ_IN), 1024, 0, 0, 2048, MAP_EVIN, 0);
            prep_w(tl, p.in[4] + (size_t)i * 256 * 768, 768, 256, p.in[3] + i * 256, (bf16_t*)(ws + W_UP + i * SZ_UP), 384, 0, 0, 768, MAP_QUP, 0);
            prep_w(tl, p.in[6] + (size_t)i * 128 * 1024, 1024, 128, p.in[5] + i * 128, (bf16_t*)(ws + W_UP + i * SZ_UP), 384, 256, 768, 1024, MAP_KVUP, 0);
            prep_w(tl, p.in[7] + (size_t)i * 1024 * 1024, 1024, 1024, nullptr, (bf16_t*)(ws + W_EOUT + i * SZ_EOUT), 1024, 0, 0, 1024, MAP_P32, 0);
            prep_w(tl, p.in[9] + (size_t)i * 1024 * 3072, 3072, 1024, p.in[8] + i * 1024, (bf16_t*)(ws + W_QKV + i * SZ_QKV), 1024, 0, 0, 3072, MAP_ODQKV, 0);
            prep_w(tl, p.in[11] + (size_t)i * 1024 * 1024, 1024, 1024, nullptr, (bf16_t*)(ws + W_OOUT + i * SZ_OOUT), 1024, 0, 0, 1024, MAP_P32, 0);
        }
        for (int L = 0; L < 4; ++L) {
            prep_w(tl, p.in[13] + (size_t)L * 1024 * 2816, 2816, 1024, p.in[12] + L * 1024, (bf16_t*)(ws + W_GU + L * SZ_GU), 1024, 0, 0, 5632, MAP_GU, 0);
            prep_w(tl, p.in[14] + (size_t)L * 1024 * 2816, 2816, 1024, p.in[12] + L * 1024, (bf16_t*)(ws + W_GU + L * SZ_GU), 1024, 0, 0, 5632, MAP_GU, 1);
            prep_w(tl, p.in[15] + (size_t)L * 2816 * 1024, 1024, 2816, nullptr, (bf16_t*)(ws + W_DN + L * SZ_DN), 2816, 0, 0, 1024, MAP_P32, 0);
        }
        for (int idx = blockIdx.x * 512 + tid; idx < 2048 * 32; idx += gridDim.x * 512) {
            const int pos = idx >> 5, i = idx & 31; const float inv = powf(10000.f, -(float)(2 * i) / 64.f), ang = (float)pos * inv;
            cosB[idx] = cosf(ang); sinB[idx] = sinf(ang);
            if (i < 16) { const float inva = powf(10000.f, -(float)(2 * i) / 32.f), anga = (float)pos * inva; cosA[pos * 16 + i] = cosf(anga); sinA[pos * 16 + i] = sinf(anga); }
        }
        float* nssq = (float*)(ws + WS_NSSQ);
        norm_phase(p.in[0], XN, nullptr, nullptr, nssq, gw, nw, lane);
    }
    xcd_barrier((unsigned*)(p.ws + WS_BAR), xcc, (volatile PG8_LAS unsigned*)(lds + pg8::STAGE_BYTES), my_tid(wid_s));
    if (p.ws == nullptr) grid.sync();

    for (int ph = 0; ph < 30 + EXTRA_N; ++ph) {
        const int lp = ph < 30 ? ph / 15 : 1, q = ph < 30 ? ph - 15 * lp : EXTRA_Q;
        __attribute__((address_space(1))) unsigned char* ws_g = (__attribute__((address_space(1))) unsigned char*)p.ws; asm volatile("" : "+s"(ws_g)); unsigned char* ws = (unsigned char*)ws_g;
        bf16_t* XN = (bf16_t*)(ws + WS_XN); bf16_t* O = (bf16_t*)(ws + WS_O); bf16_t* HFF = (bf16_t*)(ws + R_HFF);
        if (EN(0) && q == 0) {
            pg8::Gemm g{XN, (const bf16_t*)(ws + W_IN + lp * SZ_IN), T_, 2048, 1024};
            pg8::StaticOrder S; S.init(g.M, g.N, (int)gridDim.x, (int)blockIdx.x);
            EpiEvenIn E{ws, (const float*)(ws + WS_NSSQ)};
            pg8::gemm_phase<EpiEvenIn, pg8::StaticOrder, false>(lds, g, S, E, nullptr, my_tid(wid_s));
        } else if (EN(1) && q == 1) {
            pg8::Gemm g{(const bf16_t*)(ws + R_A2), (const bf16_t*)(ws + W_UP + lp * SZ_UP), T_, 1792, 384};
            pg8::StaticOrder S; S.init(g.M, g.N, (int)gridDim.x, (int)blockIdx.x);
            EpiEvenUp E{ws};
            pg8::gemm_phase<EpiEvenUp, pg8::StaticOrder, false>(lds, g, S, E, nullptr, my_tid(wid_s));
            dil_phase(lds, (const bf16_t*)(ws + R_QB), (const bf16_t*)(ws + R_KB), (const bf16_t*)(ws + R_VBT), (const bf16_t*)(ws + R_VB), O, my_tid(wid_s));
        } else if (EN(2) && q == 2) {
            const int t2 = my_tid(wid_s);
            { int nrep = NREP(8); asm volatile("" : "+s"(nrep)); for (int rep = 0; rep < nrep; ++rep)
                mla_phase(lds, (const bf16_t*)(ws + R_QA), (const bf16_t*)(ws + R_KA), (const bf16_t*)(ws + R_KPE), (const bf16_t*)(ws + R_VAT), O, t2); }
        } else if (EN(3) && (q == 3 || q == 6 || q == 10 || q == 13)) {
            const bool dn = (q == 6 || q == 13);
            const bf16_t* Bt = q == 3 ? (const bf16_t*)(ws + W_EOUT + lp * SZ_EOUT) : q == 10 ? (const bf16_t*)(ws + W_OOUT + lp * SZ_OOUT) : (const bf16_t*)(ws + W_DN + (2 * lp + (q == 13)) * SZ_DN);
            pg8::Gemm g{dn ? HFF : O, Bt, T_, 1024, dn ? 2816 : 1024};
            pg8::StaticOrder S; S.init(g.M, g.N, (int)gridDim.x, (int)blockIdx.x);
            EpiResid E{ph == 3 ? p.in[0] : nullptr, XN, (float*)(ws + WS_NSSQ)};
            pg8::gemm_phase<EpiResid, pg8::StaticOrder, false>(lds, g, S, E, nullptr, my_tid(wid_s));
        } else if (q == 4 || q == 7 || q == 11 || q == 14) {
            if (ph != 29) continue;
            const int t2 = my_tid(wid_s), lane = t2 & 63, gw = blockIdx.x * 8 + (t2 >> 6);
            final_norm_phase(XN, p.out, p.in[16], gw, nw, lane);
        } else if (EN(5) && (q == 5 || q == 12)) {
            pg8::Gemm g{XN, (const bf16_t*)(ws + W_GU + (2 * lp + (q == 12)) * SZ_GU), T_, 5632, 1024};
            pg8::StaticOrder S; S.init(g.M, g.N, (int)gridDim.x, (int)blockIdx.x);
            EpiGateUp E{HFF, (const float*)(ws + WS_NSSQ)};
            pg8::gemm_phase<EpiGateUp, pg8::StaticOrder, false>(lds, g, S, E, nullptr, my_tid(wid_s));
        } else if (EN(6) && q == 8) {
            pg8::Gemm g{XN, (const bf16_t*)(ws + W_QKV + lp * SZ_QKV), T_, 3072, 1024};
            pg8::StaticOrder S; S.init(g.M, g.N, (int)gridDim.x, (int)blockIdx.x);
            EpiOddQKV E{ws, (const float*)(ws + WS_NSSQ)};
            pg8::gemm_phase<EpiOddQKV, pg8::StaticOrder, false>(lds, g, S, E, nullptr, my_tid(wid_s));
        } else if (EN(7) && q == 9) {
            const int t2 = my_tid(wid_s);
            int nrep = NREP(7); asm volatile("" : "+s"(nrep));
            for (int rep = 0; rep < nrep; ++rep) na_phase(lds, (const bf16_t*)(ws + R_QC), (const bf16_t*)(ws + R_KC), (const bf16_t*)(ws + R_VCT), p.in[10] + (size_t)lp * 16 * 465, O, t2);
        }
        if (ph != 29 + EXTRA_N) { int nrep = NREP(11); asm volatile("" : "+s"(nrep)); for (int rep = 0; rep < nrep; ++rep) xcd_barrier((unsigned*)(ws + WS_BAR), xcc, (volatile PG8_LAS unsigned*)(lds + pg8::STAGE_BYTES), my_tid(wid_s)); }
    }
}

extern "C" void kernel_launch(void* const* d_in, const int* in_sizes, int n_in, void* d_out, int out_size, void* d_ws, size_t ws_size, hipStream_t stream) {
    constexpr int LDS_BYTES = pg8::STAGE_BYTES + 16;
    static int grid = 0;
    if (grid == 0) {
        if (n_in != 17 || out_size != T_ * 1024 || ws_size < WS_END) { fprintf(stderr, "kernel_launch: unexpected shapes (n_in %d out %d ws %zu, need %zu)\n", n_in, out_size, ws_size, (size_t)WS_END); grid = -1; return; }
        int dev = 0, cus = 0, per_cu = 0;
        hipGetDevice(&dev);
        hipDeviceGetAttribute(&cus, hipDeviceAttributeMultiprocessorCount, dev);
        if (hipFuncSetAttribute((const void*)fwd_kernel, hipFuncAttributeMaxDynamicSharedMemorySize, LDS_BYTES) != hipSuccess) { fprintf(stderr, "kernel_launch: hipFuncSetAttribute failed\n"); grid = -1; return; }
        if (hipOccupancyMaxActiveBlocksPerMultiprocessor(&per_cu, (const void*)fwd_kernel, 512, LDS_BYTES) != hipSuccess || per_cu < 1) { fprintf(stderr, "kernel_launch: occupancy query says %d\n", per_cu); per_cu = 1; }
        (void)hipGetLastError();
        grid = cus * 1;
    }
    if (grid < 0) return;
    if (hipMemsetAsync((char*)d_ws + WS_BAR, 0, XCD_BAR_WORDS * sizeof(unsigned), stream) != hipSuccess) { fprintf(stderr, "kernel_launch: memset of the barrier words failed\n"); return; }
    Params p{};
    for (int i = 0; i < 17; ++i) p.in[i] = (const float*)d_in[i];
    p.out = (float*)d_out; p.ws = (unsigned char*)d_ws;
    void* args[] = {&p};
    hipError_t e = hipLaunchCooperativeKernel((const void*)fwd_kernel, dim3(grid), dim3(512), args, LDS_BYTES, stream);
    if (e != hipSuccess) fprintf(stderr, "cooperative launch failed: %s (grid %d)\n", hipGetErrorString(e), grid);
}
```

```cpp
#include <hip/hip_runtime.h>
#include <hip/hip_cooperative_groups.h>
#include <cstdio>
#include <cstdint>
namespace cg = cooperative_groups;
namespace pg8 {
#define PG8_LAS __attribute__((address_space(3)))
typedef unsigned short bf16_t;
typedef short bf16x8 __attribute__((ext_vector_type(8)));
typedef float f32x4 __attribute__((ext_vector_type(4)));
typedef unsigned u32x4 __attribute__((ext_vector_type(4)));
constexpr int BM = 256, BK = 64, HALF = 128, HTB = HALF * BK * 2  , STAGE_BYTES = 8 * HTB, NXCD = 8, WGM = 8;

__host__ __device__ __forceinline__ int lds_byte(int r, int c) { const int st = (r >> 4) * 2 + (c >> 5), rr = r & 15, cc = c & 31, ob = rr * 64 + cc * 2; return st * 1024 + (ob ^ (((ob >> 9) & 1) << 5)); }
__host__ __device__ __forceinline__ void stage_rc(int b, int& R, int& C) { const int st = b / 1024, sb = b % 1024, swz = sb ^ (((sb >> 9) & 1) << 5); R = (st >> 1) * 16 + swz / 64; C = (st & 1) * 32 + (swz % 64) / 2; }
__host__ __device__ __forceinline__ int perm32(int rho) { const int n = rho >> 4, i = rho & 15; return 8 * (i >> 2) + 4 * n + (i & 3); }

struct Unit { int pm, pn; };
struct Gemm { const bf16_t* A; const bf16_t* Bt; int M, N, K; };

struct StaticOrder {
    int nM, nN, nwg, G, c;
    __host__ __device__ void init(int M, int N, int G_, int c_) { nM = M / BM; nN = N / BM; nwg = nM * nN; G = G_; c = c_; }
    __host__ __device__ bool next(int i, Unit& u) const {
        const long L = (long)i * G + c; if (L >= nwg) return false;
        int wgid = (int)L; { const int q = nwg / NXCD, r = nwg % NXCD, xcd = wgid % NXCD, off = wgid / NXCD; wgid = (xcd < r ? xcd * (q + 1) : r * (q + 1) + (xcd - r) * q) + off; }
        const int nig = WGM * nN, gid = wgid / nig, fm = gid * WGM, gsz = (nM - fm) < WGM ? (nM - fm) : WGM;
        u.pm = fm + ((wgid % nig) % gsz); u.pn = (wgid % nig) / gsz; return true;
    }
    __device__ __forceinline__ void a_ready(const Unit&) const {}
    __device__ __forceinline__ void done(const Unit&) const {}
};
template <class Epi, class Sched, bool STAMP = false>
__device__ __forceinline__ void gemm_phase(PG8_LAS unsigned char* lds, const Gemm g, const Sched& S, const Epi& E, unsigned long long* stamps, int tid_in) {
    int tid_l = tid_in; asm volatile("" : "+v"(tid_l));
    const int tid = tid_l, wid = __builtin_amdgcn_readfirstlane(tid >> 6), lane = tid & 63, wr = wid >> 2, wc = wid & 3, fr = lane & 15, fq = lane >> 4;
    const int K = g.K, nt = K / BK;
    int ts_lo = 0, ts_hi = 0, nts = 0; const unsigned long long rt_entry = STAMP ? (unsigned long long)wall_clock64() : 0ull;
#define PG8_STAMP() do { if (STAMP && wid == 0 && nts < 64) { const unsigned long long _c = (unsigned long long)clock64(); \
        ts_lo = (lane == nts) ? (int)(unsigned)_c : ts_lo; ts_hi = (lane == nts) ? (int)(unsigned)(_c >> 32) : ts_hi; ++nts; } } while (0)
    PG8_STAMP();
    unsigned voffA[2], voffB[2];
#pragma unroll
    for (int i = 0; i < 2; ++i) { int R, C; stage_rc(tid * 16 + i * 8192, R, C); const int Rb = Epi::PERM ? ((R & ~31) + perm32(R & 31)) : R;
        voffA[i] = (unsigned)(R * K + C) * 2u; voffB[i] = (unsigned)(Rb * K + C) * 2u; }
    const size_t kstep = (size_t)(BK * 2);
    const size_t hstep = (size_t)HALF * K * 2;
    const size_t tstep = 2 * hstep;
    const unsigned ldsw = (unsigned)wid * 1024u;
    const int aoff = lds_byte(wr * 64 + fr, fq * 8), boff = lds_byte(wc * 32 + fr, fq * 8);
#define PG8_SA(b, h) (((b) * 2 + (h)) * HTB)
#define PG8_SB(b, h) ((4 + (b) * 2 + (h)) * HTB)
#define PG8_STAGE(bufoff, gbase, voff) do { _Pragma("unroll") for (int _i = 0; _i < 2; ++_i) \
        __builtin_amdgcn_global_load_lds((const unsigned*)((const char*)(gbase) + (voff)[_i]), (PG8_LAS unsigned*)(lds + (bufoff) + ldsw + _i * 8192), 16, 0, 0); } while (0)
#define PG8_LDA(dst, b, h) do { _Pragma("unroll") for (int m = 0; m < 4; ++m) _Pragma("unroll") for (int k = 0; k < 2; ++k) dst[m][k] = *(const PG8_LAS bf16x8*)(lds + PG8_SA(b, h) + aoff + m * 2048 + k * 1024); } while (0)
#define PG8_LDB(dst, b, h) do { _Pragma("unroll") for (int n = 0; n < 2; ++n) _Pragma("unroll") for (int k = 0; k < 2; ++k) dst[n][k] = *(const PG8_LAS bf16x8*)(lds + PG8_SB(b, h) + boff + n * 2048 + k * 1024); } while (0)
#define PG8_MMA(ai, bj, At, Bt) do { __builtin_amdgcn_s_setprio(1); _Pragma("unroll") for (int m = 0; m < 4; ++m) _Pragma("unroll") for (int n = 0; n < 2; ++n) _Pragma("unroll") for (int k = 0; k < 2; ++k) \
        acc[ai][bj][m][n] = __builtin_amdgcn_mfma_f32_16x16x32_bf16(Bt[n][k], At[m][k], acc[ai][bj][m][n], 0, 0, 0); __builtin_amdgcn_s_setprio(0); } while (0)
#define PG8_WAIT_V(n) asm volatile("s_waitcnt vmcnt(" #n ")" ::: "memory")
#define PG8_WAIT_L(n) asm volatile("s_waitcnt lgkmcnt(" #n ")" ::: "memory")
#define PG8_BAR __builtin_amdgcn_s_barrier()
#define PG8_SCHED __builtin_amdgcn_sched_barrier(0)
    Unit cur, nxt; int ui = 0;
    if (!S.next(0, cur)) return;
    f32x4 acc[2][2][4][2];
#pragma unroll
    for (int a = 0; a < 2; ++a)
#pragma unroll
        for (int b = 0; b < 2; ++b)
#pragma unroll
            for (int m = 0; m < 4; ++m)
#pragma unroll
                for (int n = 0; n < 2; ++n) acc[a][b][m][n] = (f32x4){0.f, 0.f, 0.f, 0.f};
    bf16x8 At[4][2], B0[2][2], B1[2][2];
    const char* cA = (const char*)g.A + (size_t)cur.pm * tstep; const char* cB = (const char*)g.Bt + (size_t)cur.pn * tstep;
    float carry[2][4];
    if constexpr (Epi::CARRY) E.init_carry(cur, carry, wr, fr, fq);
    S.a_ready(cur);
    PG8_STAGE(PG8_SB(0, 0), cB, voffB); PG8_STAGE(PG8_SA(0, 0), cA, voffA); PG8_STAGE(PG8_SB(0, 1), cB + hstep, voffB); PG8_STAGE(PG8_SA(0, 1), cA + hstep, voffA);
    if (wr == 1) PG8_BAR;
    PG8_WAIT_V(4); PG8_BAR;
    PG8_STAGE(PG8_SB(1, 0), cB + kstep, voffB); PG8_STAGE(PG8_SA(1, 0), cA + kstep, voffA); PG8_STAGE(PG8_SB(1, 1), cB + hstep + kstep, voffB);
    PG8_WAIT_V(6); PG8_BAR;
    PG8_STAMP();
    for (;;) {
        const bool has_next = S.next(ui + 1, nxt);
        const char* nA = has_next ? (const char*)g.A + (size_t)nxt.pm * tstep : cA; const char* nB = has_next ? (const char*)g.Bt + (size_t)nxt.pn * tstep : cB;
        for (int t = 0; t < nt; t += 2) {
            const bool last = (t == nt - 2);
            const char* a1 = cA + (size_t)(t + 1) * kstep;
            const char* a2 = last ? nA : cA + (size_t)(t + 2) * kstep; const char* b2 = last ? nB : cB + (size_t)(t + 2) * kstep;
            const char* a3 = a2 + kstep; const char* b3 = b2 + kstep;
            if (last && has_next) S.a_ready(nxt);
            PG8_LDB(B0, 0, 0); PG8_SCHED; PG8_LDA(At, 0, 0); PG8_STAGE(PG8_SA(1, 1), a1 + hstep, voffA);
            PG8_WAIT_L(8); PG8_BAR; PG8_WAIT_L(0); PG8_MMA(0, 0, At, B0); PG8_BAR; PG8_SCHED;
            PG8_LDB(B1, 0, 1); PG8_STAGE(PG8_SB(0, 0), b2, voffB);
            PG8_BAR; PG8_WAIT_L(0); PG8_MMA(0, 1, At, B1); PG8_BAR;
            PG8_LDA(At, 0, 1); PG8_STAGE(PG8_SA(0, 0), a2, voffA);
            PG8_BAR; PG8_WAIT_L(0); PG8_MMA(1, 0, At, B0); PG8_BAR; PG8_SCHED;
            PG8_STAGE(PG8_SB(0, 1), b2 + hstep, voffB);
            PG8_WAIT_V(6); PG8_BAR; PG8_MMA(1, 1, At, B1); PG8_BAR;
            PG8_LDB(B0, 1, 0); PG8_SCHED; PG8_LDA(At, 1, 0); PG8_STAGE(PG8_SA(0, 1), a2 + hstep, voffA);
            PG8_WAIT_L(8); PG8_BAR; PG8_WAIT_L(0); PG8_MMA(0, 0, At, B0); PG8_BAR; PG8_SCHED;
            PG8_LDB(B1, 1, 1); PG8_STAGE(PG8_SB(1, 0), b3, voffB);
            PG8_BAR; PG8_WAIT_L(0); PG8_MMA(0, 1, At, B1); PG8_BAR;
            PG8_LDA(At, 1, 1); PG8_STAGE(PG8_SA(1, 0), a3, voffA);
            PG8_BAR; PG8_WAIT_L(0); PG8_MMA(1, 0, At, B0); PG8_BAR; PG8_SCHED;
            PG8_STAGE(PG8_SB(1, 1), b3 + hstep, voffB);
            PG8_WAIT_V(6); PG8_BAR; PG8_MMA(1, 1, At, B1); PG8_BAR;
        }
        PG8_STAMP();
        if (wr == 0) PG8_BAR;
        if constexpr (Epi::CARRY) { E.run(acc, cur, nxt, has_next, carry, wr, wc, fr, fq); S.done(cur); }
        else if constexpr (!Epi::AFTER_DRAIN) { E(acc, cur, wr, wc, fr, fq); S.done(cur); }
        PG8_STAMP();
        if (!has_next) break;
#pragma unroll
        for (int a = 0; a < 2; ++a)
#pragma unroll
            for (int b = 0; b < 2; ++b)
#pragma unroll
                for (int m = 0; m < 4; ++m)
#pragma unroll
                    for (int n = 0; n < 2; ++n) acc[a][b][m][n] = (f32x4){0.f, 0.f, 0.f, 0.f};
        cur = nxt; cA = nA; cB = nB; ++ui;
        if (wr == 1) PG8_BAR;
    }
    PG8_WAIT_V(0);
    PG8_BAR;
    if constexpr (Epi::AFTER_DRAIN) { E.fused(acc, cur, wr, wc, fr, fq, lds, wid, lane); S.done(cur); }
    PG8_STAMP();
    if (STAMP && wid == 0) { stamps[lane] = lane < nts ? (((unsigned long long)(unsigned)ts_hi << 32) | (unsigned)ts_lo) : 0ull;
        if (lane == 62) stamps[62] = rt_entry; if (lane == 63) stamps[63] = (unsigned long long)wall_clock64(); }
#undef PG8_STAMP
#undef PG8_SA
#undef PG8_SB
#undef PG8_STAGE
#undef PG8_LDA
#undef PG8_LDB
#undef PG8_MMA
#undef PG8_WAIT_V
#undef PG8_WAIT_L
#undef PG8_BAR
#undef PG8_SCHED
}
}

using pg8::bf16_t;
using pg8::f32x4;
using pg8::u32x4;
using pg8::Unit;
typedef short bf16x8 __attribute__((ext_vector_type(8)));
typedef float f32x16 __attribute__((ext_vector_type(16)));
typedef unsigned u32x2 __attribute__((ext_vector_type(2)));
typedef short s16x4 __attribute__((ext_vector_type(4)));

#ifndef ENMASK
#define ENMASK 0xffff
#endif
#define EN(k) ((ENMASK >> (k)) & 1)
#ifndef REPMASK
#define REPMASK 0
#endif
#define NREP(k) (1 + ((REPMASK >> (k)) & 1))
#ifndef EXTRA_N
#define EXTRA_N 0
#endif
#ifndef EXTRA_Q
#define EXTRA_Q 5
#endif
constexpr int T_ = 32768, S_ = 2048;
constexpr float EPSV = 1e-6f;
constexpr float LOG2E = 1.4426950408889634f;
constexpr size_t MiB = (size_t)1 << 20;
constexpr size_t WS_COSA = 0, WS_SINA = 128 * 1024, WS_COSB = 256 * 1024, WS_SINB = 512 * 1024;
constexpr size_t WS_SSQ = 1 * MiB;
constexpr size_t WS_W = 2 * MiB;
constexpr size_t W_IN = WS_W, W_UP = WS_W + 8 * MiB, W_EOUT = WS_W + 11 * MiB, W_QKV = WS_W + 15 * MiB, W_OOUT = WS_W + 27 * MiB, W_GU = WS_W + 31 * MiB, W_DN = WS_W + 75 * MiB;
constexpr size_t SZ_IN = 4 * MiB, SZ_UP = 3 * MiB / 2, SZ_EOUT = 2 * MiB, SZ_QKV = 6 * MiB, SZ_OOUT = 2 * MiB, SZ_GU = 11 * MiB, SZ_DN = 11 * MiB / 2;
constexpr size_t WS_XN = 100 * MiB, WS_O = 164 * MiB, WS_R = 228 * MiB;
constexpr size_t R_QB = WS_R, R_KB = WS_R + 32 * MiB, R_VBT = WS_R + 64 * MiB, R_A2 = WS_R + 96 * MiB, R_KPE = WS_R + 120 * MiB, R_QA = WS_R + 122 * MiB, R_KA = WS_R + 170 * MiB, R_VAT = WS_R + 202 * MiB;
constexpr size_t R_QC = WS_R, R_KC = WS_R + 64 * MiB, R_VCT = WS_R + 128 * MiB;
constexpr size_t R_HFF = WS_R;
constexpr size_t R_VB = WS_R + 234 * MiB;
constexpr size_t WS_NSSQ = WS_R + 266 * MiB;
constexpr size_t WS_END = WS_NSSQ + 2 * MiB;
constexpr size_t WS_BAR = 896 * 1024;

struct Params {
    const float* in[17];
    float* out;
    unsigned char* ws;
};

__device__ __forceinline__ unsigned cvt_pk_bf16(float lo, float hi) { unsigned r; asm("v_cvt_pk_bf16_f32 %0, %1, %2" : "=v"(r) : "v"(lo), "v"(hi)); return r; }
__device__ __forceinline__ bf16_t f2bf(float f) { return (bf16_t)(cvt_pk_bf16(f, 0.f) & 0xffffu); }
__device__ __forceinline__ float xshfl(float v, int lane, int mask) { return __builtin_bit_cast(float, __builtin_amdgcn_ds_bpermute((lane ^ mask) << 2, __builtin_bit_cast(int, v))); }
__device__ __forceinline__ float fexp2(float x) { return __builtin_amdgcn_exp2f(x); }
__device__ __forceinline__ u32x2 pk4(f32x4 v) { u32x2 o; o.x = cvt_pk_bf16(v[0], v[1]); o.y = cvt_pk_bf16(v[2], v[3]); return o; }
__device__ __forceinline__ u32x4 pk8(f32x4 a, f32x4 b) { u32x4 o; o.x = cvt_pk_bf16(a[0], a[1]); o.y = cvt_pk_bf16(a[2], a[3]); o.z = cvt_pk_bf16(b[0], b[1]); o.w = cvt_pk_bf16(b[2], b[3]); return o; }


#define XB_TMO      128
#define XB_XCNT(j)  (256  + 64 * (j))
#define XB_XSUB(j)  (1280 + 64 * (j))
#define XB_XGEN(j)  (2304 + 64 * (j))
#define XB_TOP      3328
#define XB_TOPGEN   3392
#define XCD_BAR_WORDS 3456
#define XB_SPIN_CAP (1u << 20)
__device__ __forceinline__ unsigned xb_ld(unsigned* p)              { return __hip_atomic_load(p, __ATOMIC_RELAXED, __HIP_MEMORY_SCOPE_AGENT); }
__device__ __forceinline__ unsigned xb_add(unsigned* p, unsigned v) { return __hip_atomic_fetch_add(p, v, __ATOMIC_RELAXED, __HIP_MEMORY_SCOPE_AGENT); }
__device__ __forceinline__ unsigned xb_xcc_id() { return (unsigned)__builtin_amdgcn_s_getreg((3 << 11) | 20) & 0xFu; }
#define XB_SPIN(cond, bar) do { unsigned _sp = 0; while (cond) { __builtin_amdgcn_s_sleep(1); \
    if ((++_sp & 255u) == 0u) { if (xb_ld(&(bar)[XB_TMO])) break; if (_sp > XB_SPIN_CAP) { atomicAdd(&(bar)[XB_TMO], 1u); break; } } } } while (0)
__device__ __forceinline__ void xcd_barrier_complete(unsigned* bar, unsigned x, unsigned& nloc, unsigned& nx) {
    const unsigned G = gridDim.x;
    unsigned sum, cnt, mine, sp = 0u;
    for (;;) {
        sum = 0u; cnt = 0u; mine = 0u;
#pragma unroll
        for (unsigned j = 0; j < 16; ++j) { const unsigned c = xb_ld(&bar[XB_XCNT(j)]); sum += c; cnt += (c > 0u) ? 1u : 0u; mine = (j == x) ? c : mine; }
        if (sum == G) break;
        __builtin_amdgcn_s_sleep(1);
        if ((++sp & 255u) == 0u) { if (xb_ld(&bar[XB_TMO])) break; if (sp > XB_SPIN_CAP) { atomicAdd(&bar[XB_TMO], 1u); break; } }
    }
    nloc = mine > 0u ? mine : 1u; nx = cnt > 0u ? cnt : 1u;
}
__device__ __forceinline__ void xcd_barrier(unsigned* bar, unsigned x, volatile PG8_LAS unsigned* st, int tid) {
    asm volatile("s_waitcnt vmcnt(0)" ::: "memory");
    __syncthreads();
    if (tid == 0) {
        __builtin_amdgcn_s_waitcnt(0);
        unsigned nloc = st[0], nx = st[1];
        if (nloc == 0u) { xcd_barrier_complete(bar, x, nloc, nx); st[0] = nloc; st[1] = nx; }
        const unsigned old = xb_add(&bar[XB_XSUB(x)], 1u);
        const unsigned gen = old / nloc;
        if (old + 1u == (gen + 1u) * nloc) {
            __builtin_amdgcn_fence(__ATOMIC_RELEASE, "agent");
            asm volatile("s_waitcnt vmcnt(0)" ::: "memory");
            const unsigned og = xb_add(&bar[XB_TOP], 1u);
            const unsigned tg = og / nx;
            if (og + 1u == (tg + 1u) * nx) xb_add(&bar[XB_TOPGEN], 1u);
            else XB_SPIN(xb_ld(&bar[XB_TOPGEN]) == tg, bar);
            __builtin_amdgcn_fence(__ATOMIC_ACQUIRE, "agent");
            xb_add(&bar[XB_XGEN(x)], 1u);
            asm volatile("s_waitcnt vmcnt(0)" ::: "memory");
        } else {
            XB_SPIN(xb_ld(&bar[XB_XGEN(x)]) == gen, bar);
            __builtin_amdgcn_fence(__ATOMIC_ACQUIRE, "agent");
            asm volatile("s_waitcnt vmcnt(0)" ::: "memory");
        }
    }
    __syncthreads();
}

__device__ __forceinline__ void row_rs8(const float* __restrict__ nssq, int row0, int fr, int fq, float (&rs)[2][4]) {
    f32x4 part[2][4];
#pragma unroll
    for (int ai = 0; ai < 2; ++ai)
#pragma unroll
        for (int m = 0; m < 4; ++m) part[ai][m] = *(const f32x4*)(nssq + (size_t)(row0 + ai * 128 + m * 16) * 16 + 4 * fq);
#pragma unroll
    for (int ai = 0; ai < 2; ++ai)
#pragma unroll
        for (int m = 0; m < 4; ++m) { float s = part[ai][m][0] + part[ai][m][1] + part[ai][m][2] + part[ai][m][3];
            s += xshfl(s, fr + 16 * fq, 16); s += xshfl(s, fr + 16 * fq, 32);
            rs[ai][m] = rsqrtf(s * (1.f / 1024.f) + EPSV); }
}
struct EpiResid {
    static constexpr bool PERM = false, AFTER_DRAIN = false, CARRY = false;
    const float* x0; bf16_t* xn; float* nssq;
    __device__ __forceinline__ void operator()(const f32x4 (&acc)[2][2][4][2], const Unit& u, int wr, int wc, int fr, int fq) const {
        asm volatile("" : "+v"(fr), "+v"(fq));
        const int row0 = u.pm * 256 + wr * 64 + fr, col0 = u.pn * 256 + wc * 32 + 8 * fq;
        float ssv[2][4];
#pragma unroll
        for (int ai = 0; ai < 2; ++ai) {
            f32x4 hv[4][2][2];
            if (x0) {
#pragma unroll
                for (int m = 0; m < 4; ++m)
#pragma unroll
                    for (int bj = 0; bj < 2; ++bj)
#pragma unroll
                        for (int n = 0; n < 2; ++n) hv[m][bj][n] = *(const f32x4*)(x0 + (size_t)(row0 + ai * 128 + m * 16) * 1024 + col0 + bj * 128 + n * 4);
            } else {
                u32x4 hb[4][2];
#pragma unroll
                for (int m = 0; m < 4; ++m)
#pragma unroll
                    for (int bj = 0; bj < 2; ++bj) hb[m][bj] = *(const u32x4*)(xn + (size_t)(row0 + ai * 128 + m * 16) * 1024 + col0 + bj * 128);
#pragma unroll
                for (int m = 0; m < 4; ++m)
#pragma unroll
                    for (int bj = 0; bj < 2; ++bj) { const u32x4 t = hb[m][bj]; f32x4 v0, v1;
                        v0[0] = __uint_as_float(t.x << 16); v0[1] = __uint_as_float(t.x & 0xffff0000u); v0[2] = __uint_as_float(t.y << 16); v0[3] = __uint_as_float(t.y & 0xffff0000u);
                        v1[0] = __uint_as_float(t.z << 16); v1[1] = __uint_as_float(t.z & 0xffff0000u); v1[2] = __uint_as_float(t.w << 16); v1[3] = __uint_as_float(t.w & 0xffff0000u);
                        hv[m][bj][0] = v0; hv[m][bj][1] = v1; }
            }
#pragma unroll
            for (int m = 0; m < 4; ++m) { const int row = row0 + ai * 128 + m * 16; float ss = 0.f;
#pragma unroll
                for (int bj = 0; bj < 2; ++bj) { const u32x4 pk = pk8(hv[m][bj][0] + acc[ai][bj][m][0], hv[m][bj][1] + acc[ai][bj][m][1]);
                    *(u32x4*)(xn + (size_t)row * 1024 + col0 + bj * 128) = pk;
                    const float r0 = __uint_as_float(pk.x << 16), r1 = __uint_as_float(pk.x & 0xffff0000u), r2 = __uint_as_float(pk.y << 16), r3 = __uint_as_float(pk.y & 0xffff0000u);
                    const float r4 = __uint_as_float(pk.z << 16), r5 = __uint_as_float(pk.z & 0xffff0000u), r6 = __uint_as_float(pk.w << 16), r7 = __uint_as_float(pk.w & 0xffff0000u);
                    ss += r0 * r0 + r1 * r1 + r2 * r2 + r3 * r3 + r4 * r4 + r5 * r5 + r6 * r6 + r7 * r7; }
                ss += xshfl(ss, fr + 16 * fq, 16); ss += xshfl(ss, fr + 16 * fq, 32);
                ssv[ai][m] = ss; }
            __builtin_amdgcn_sched_barrier(0);
        }
#pragma unroll
        for (int ai = 0; ai < 2; ++ai) { const float v = fq == 0 ? ssv[ai][0] : fq == 1 ? ssv[ai][1] : fq == 2 ? ssv[ai][2] : ssv[ai][3];
            nssq[(size_t)(row0 + ai * 128 + fq * 16) * 16 + 4 * u.pn + wc] = v; }
    }
};
struct EpiGateUp {
    static constexpr bool PERM = false, AFTER_DRAIN = false, CARRY = true;
    bf16_t* hff; const float* nssq;
    __device__ __forceinline__ void init_carry(const Unit& u, float (&carry)[2][4], int wr, int fr, int fq) const { row_rs8(nssq, u.pm * 256 + wr * 64 + fr, fr, fq, carry); }
    __device__ __forceinline__ void run(const f32x4 (&acc)[2][2][4][2], const Unit& u, const Unit& nx, bool has_next, float (&carry)[2][4], int wr, int wc, int fr, int fq) const {
        asm volatile("" : "+v"(fr), "+v"(fq));
        const int row0 = u.pm * 256 + wr * 64 + fr, fcol = u.pn * 128 + wc * 32 + 8 * fq;
        const int nrow0 = (has_next ? nx.pm : u.pm) * 256 + wr * 64 + fr;
        f32x4 part[2][4];
#pragma unroll
        for (int ai = 0; ai < 2; ++ai)
#pragma unroll
            for (int m = 0; m < 4; ++m) part[ai][m] = *(const f32x4*)(nssq + (size_t)(nrow0 + ai * 128 + m * 16) * 16 + 4 * fq);
#pragma unroll
        for (int ai = 0; ai < 2; ++ai)
#pragma unroll
            for (int m = 0; m < 4; ++m) {
                const float rs = carry[ai][m];
                f32x4 r0, r1;
#pragma unroll
                for (int j = 0; j < 4; ++j) {
                    const float g0 = acc[ai][0][m][0][j] * rs, g1 = acc[ai][0][m][1][j] * rs;
                    r0[j] = g0 * __builtin_amdgcn_rcpf(1.f + fexp2(-g0 * LOG2E)) * (acc[ai][1][m][0][j] * rs);
                    r1[j] = g1 * __builtin_amdgcn_rcpf(1.f + fexp2(-g1 * LOG2E)) * (acc[ai][1][m][1][j] * rs);
                }
                *(u32x4*)(hff + (size_t)(row0 + ai * 128 + m * 16) * 2816 + fcol) = pk8(r0, r1);
            }
#pragma unroll
        for (int ai = 0; ai < 2; ++ai)
#pragma unroll
            for (int m = 0; m < 4; ++m) { float sq = part[ai][m][0] + part[ai][m][1] + part[ai][m][2] + part[ai][m][3];
                sq += xshfl(sq, fr + 16 * fq, 16); sq += xshfl(sq, fr + 16 * fq, 32);
                carry[ai][m] = rsqrtf(sq * (1.f / 1024.f) + EPSV); }
    }
};
struct EpiEvenIn {
    static constexpr bool PERM = false, AFTER_DRAIN = false, CARRY = false;
    unsigned char* ws; const float* nssq;
    __device__ __forceinline__ void operator()(const f32x4 (&acc)[2][2][4][2], const Unit& u, int wr, int wc, int fr, int fq) const {
        asm volatile("" : "+v"(fr), "+v"(fq));
        bf16_t* const qb = (bf16_t*)(ws + R_QB); bf16_t* const kb = (bf16_t*)(ws + R_KB); bf16_t* const vbt = (bf16_t*)(ws + R_VBT); bf16_t* const a2 = (bf16_t*)(ws + R_A2); bf16_t* const kpe = (bf16_t*)(ws + R_KPE);
        float* const ssq = (float*)(ws + WS_SSQ); const float* const cosA = (const float*)(ws + WS_COSA); const float* const sinA = (const float*)(ws + WS_SINA); const float* const cosB = (const float*)(ws + WS_COSB); const float* const sinB = (const float*)(ws + WS_SINB);
        const int row0 = u.pm * 256 + wr * 64 + fr, pn = u.pn;
        float rs8[2][4]; row_rs8(nssq, row0, fr, fq, rs8);
        if (pn < 4) {
            bf16_t* dst = pn < 2 ? qb : kb; const float sc = pn < 2 ? 0.125f * LOG2E : 1.f;
            const int hcol = (4 * (pn & 1) + wc) * 64 + 8 * fq;
#pragma unroll
            for (int ai = 0; ai < 2; ++ai) {
                f32x4 cc[4][2], sn[4][2];
#pragma unroll
                for (int m = 0; m < 4; ++m)
#pragma unroll
                    for (int n = 0; n < 2; ++n) { const int pos = (row0 + ai * 128 + m * 16) & 2047; cc[m][n] = *(const f32x4*)(cosB + pos * 32 + 8 * fq + 4 * n); sn[m][n] = *(const f32x4*)(sinB + pos * 32 + 8 * fq + 4 * n); }
#pragma unroll
                for (int m = 0; m < 4; ++m) { const int row = row0 + ai * 128 + m * 16; const float rsc = rs8[ai][m] * sc;
                    f32x4 o1[2], o2[2];
#pragma unroll
                    for (int n = 0; n < 2; ++n) { const f32x4 x1 = acc[ai][0][m][n], x2 = acc[ai][1][m][n];
                        o1[n] = (x1 * cc[m][n] - x2 * sn[m][n]) * rsc; o2[n] = (x2 * cc[m][n] + x1 * sn[m][n]) * rsc; }
                    bf16_t* p = dst + (size_t)row * 512 + hcol;
                    *(u32x4*)p = pk8(o1[0], o1[1]); *(u32x4*)(p + 32) = pk8(o2[0], o2[1]); }
                __builtin_amdgcn_sched_barrier(0);
            }
        } else if (pn < 6) {
            bf16_t* const vb = (bf16_t*)(ws + R_VB);
#pragma unroll
            for (int ai = 0; ai < 2; ++ai)
#pragma unroll
                for (int m = 0; m < 4; ++m) { const int row = row0 + ai * 128 + m * 16, pos = row & 2047, b = row >> 11; const float rs = rs8[ai][m];
#pragma unroll
                    for (int bj = 0; bj < 2; ++bj) { const int f0 = (pn - 4) * 256 + bj * 128 + wc * 32 + 8 * fq;
                        const f32x4 y0 = acc[ai][bj][m][0] * rs, y1 = acc[ai][bj][m][1] * rs;
                        *(u32x4*)(vb + (size_t)row * 512 + f0) = pk8(y0, y1);
                    }
                    __builtin_amdgcn_sched_barrier(0); }
        } else if (pn == 6) {
            float ssv[2][4];
#pragma unroll
            for (int ai = 0; ai < 2; ++ai)
#pragma unroll
                for (int m = 0; m < 4; ++m) { const int row = row0 + ai * 128 + m * 16; float ss = 0.f; const float rs = rs8[ai][m];
#pragma unroll
                    for (int bj = 0; bj < 2; ++bj) { const f32x4 v0 = acc[ai][bj][m][0] * rs, v1 = acc[ai][bj][m][1] * rs;
#pragma unroll
                        for (int j = 0; j < 4; ++j) ss += v0[j] * v0[j] + v1[j] * v1[j];
                        *(u32x4*)(a2 + (size_t)row * 384 + bj * 128 + wc * 32 + 8 * fq) = pk8(v0, v1); }
                    ss += xshfl(ss, fr + 16 * fq, 16); ss += xshfl(ss, fr + 16 * fq, 32);
                    ssv[ai][m] = ss; }
#pragma unroll
            for (int ai = 0; ai < 2; ++ai) ssq[(size_t)(row0 + ai * 128 + fq * 16) * 8 + wc] = fq == 0 ? ssv[ai][0] : fq == 1 ? ssv[ai][1] : fq == 2 ? ssv[ai][2] : ssv[ai][3];
        } else {
            float ssv[2][4];
#pragma unroll
            for (int ai = 0; ai < 2; ++ai) {
                f32x4 cc[4], sn[4];
                if (wc == 0) {
#pragma unroll
                    for (int m = 0; m < 4; ++m) { const int pos = (row0 + ai * 128 + m * 16) & 2047; cc[m] = *(const f32x4*)(cosA + pos * 16 + 4 * fq); sn[m] = *(const f32x4*)(sinA + pos * 16 + 4 * fq); }
                }
#pragma unroll
                for (int m = 0; m < 4; ++m) { const int row = row0 + ai * 128 + m * 16; float ss = 0.f; const float rs = rs8[ai][m];
                    { const f32x4 v0 = acc[ai][0][m][0] * rs, v1 = acc[ai][0][m][1] * rs;
#pragma unroll
                      for (int j = 0; j < 4; ++j) ss += v0[j] * v0[j] + v1[j] * v1[j];
                      *(u32x4*)(a2 + (size_t)row * 384 + 256 + wc * 32 + 8 * fq) = pk8(v0, v1); }
                    ss += xshfl(ss, fr + 16 * fq, 16); ss += xshfl(ss, fr + 16 * fq, 32);
                    ssv[ai][m] = ss;
                    if (wc == 0) { const f32x4 x1 = acc[ai][1][m][0] * rs, x2 = acc[ai][1][m][1] * rs;
                        bf16_t* p = kpe + (size_t)row * 32 + 4 * fq;
                        *(u32x2*)p = pk4(x1 * cc[m] - x2 * sn[m]); *(u32x2*)(p + 16) = pk4(x2 * cc[m] + x1 * sn[m]); } }
                __builtin_amdgcn_sched_barrier(0);
            }
#pragma unroll
            for (int ai = 0; ai < 2; ++ai) ssq[(size_t)(row0 + ai * 128 + fq * 16) * 8 + 4 + wc] = fq == 0 ? ssv[ai][0] : fq == 1 ? ssv[ai][1] : fq == 2 ? ssv[ai][2] : ssv[ai][3];
        }
    }
};
struct EpiEvenUp {
    static constexpr bool PERM = false, AFTER_DRAIN = false, CARRY = false;
    unsigned char* ws;
    __device__ __forceinline__ void operator()(const f32x4 (&acc)[2][2][4][2], const Unit& u, int wr, int wc, int fr, int fq) const {
        asm volatile("" : "+v"(fr), "+v"(fq));
        bf16_t* const qa = (bf16_t*)(ws + R_QA); bf16_t* const ka = (bf16_t*)(ws + R_KA); bf16_t* const vat = (bf16_t*)(ws + R_VAT);
        const float* const ssq = (const float*)(ws + WS_SSQ); const float* const cosA = (const float*)(ws + WS_COSA); const float* const sinA = (const float*)(ws + WS_SINA);
        const int row0 = u.pm * 256 + wr * 64 + fr, pn = u.pn;
        float rs8[2][4];
        { f32x4 q[2][4];
#pragma unroll
          for (int ai = 0; ai < 2; ++ai)
#pragma unroll
              for (int m = 0; m < 4; ++m) q[ai][m] = *(const f32x4*)(ssq + (size_t)(row0 + ai * 128 + m * 16) * 8 + (pn < 3 ? 0 : 4));
          const float dinv = pn < 3 ? (1.f / 256.f) : (1.f / 128.f), mul = pn < 3 ? (0.10206207261596575f * LOG2E) : 1.f;
#pragma unroll
          for (int ai = 0; ai < 2; ++ai)
#pragma unroll
              for (int m = 0; m < 4; ++m) rs8[ai][m] = rsqrtf((q[ai][m][0] + q[ai][m][1] + q[ai][m][2] + q[ai][m][3]) * dinv + EPSV) * mul; }
        if (pn < 3) {
            int hoff[2], part[2];
#pragma unroll
            for (int bj = 0; bj < 2; ++bj) { const int G = 8 * pn + 4 * bj + wc, head = G / 3; part[bj] = G - 3 * head; hoff[bj] = head * 96 + (part[bj] < 2 ? 32 * part[bj] + 8 * fq : 64 + 4 * fq); }
            const bool anyrope = (part[0] == 2) || (part[1] == 2);
#pragma unroll
            for (int ai = 0; ai < 2; ++ai) {
                f32x4 cc[4], sn[4];
                if (anyrope) {
#pragma unroll
                    for (int m = 0; m < 4; ++m) { const int pos = (row0 + ai * 128 + m * 16) & 2047; cc[m] = *(const f32x4*)(cosA + pos * 16 + 4 * fq); sn[m] = *(const f32x4*)(sinA + pos * 16 + 4 * fq); }
                }
#pragma unroll
                for (int m = 0; m < 4; ++m) { const int row = row0 + ai * 128 + m * 16; const float rs = rs8[ai][m];
#pragma unroll
                    for (int bj = 0; bj < 2; ++bj) {
                        const f32x4 x1 = acc[ai][bj][m][0] * rs, x2 = acc[ai][bj][m][1] * rs;
                        bf16_t* p = qa + (size_t)row * 768 + hoff[bj];
                        if (part[bj] < 2) *(u32x4*)p = pk8(x1, x2);
                        else { *(u32x2*)p = pk4(x1 * cc[m] - x2 * sn[m]); *(u32x2*)(p + 16) = pk4(x2 * cc[m] + x1 * sn[m]); } } }
                __builtin_amdgcn_sched_barrier(0);
            }
        } else {
            int head[2], part[2];
#pragma unroll
            for (int bj = 0; bj < 2; ++bj) { const int G = 8 * (pn - 3) + 4 * bj + wc; head[bj] = G >> 2; part[bj] = G & 3; }
#pragma unroll
            for (int ai = 0; ai < 2; ++ai)
#pragma unroll
                for (int m = 0; m < 4; ++m) { const int row = row0 + ai * 128 + m * 16, pos = row & 2047, b = row >> 11; const float rs = rs8[ai][m];
#pragma unroll
                    for (int bj = 0; bj < 2; ++bj) {
                        const f32x4 x1 = acc[ai][bj][m][0] * rs, x2 = acc[ai][bj][m][1] * rs;
                        if (part[bj] < 2) *(u32x4*)(ka + (size_t)row * 512 + head[bj] * 64 + 32 * part[bj] + 8 * fq) = pk8(x1, x2);
                        else *(u32x4*)(vat + (size_t)row * 512 + head[bj] * 64 + 32 * (part[bj] - 2) + 8 * fq) = pk8(x1, x2); }
                    __builtin_amdgcn_sched_barrier(0); }
        }
    }
};
struct EpiOddQKV {
    static constexpr bool PERM = false, AFTER_DRAIN = false, CARRY = false;
    unsigned char* ws; const float* nssq;
    __device__ __forceinline__ void operator()(const f32x4 (&acc)[2][2][4][2], const Unit& u, int wr, int wc, int fr, int fq) const {
        asm volatile("" : "+v"(fr), "+v"(fq));
        bf16_t* const qc = (bf16_t*)(ws + R_QC); bf16_t* const kc = (bf16_t*)(ws + R_KC); bf16_t* const vct = (bf16_t*)(ws + R_VCT);
        const int row0 = u.pm * 256 + wr * 64 + fr, pn = u.pn;
        float rs8[2][4]; row_rs8(nssq, row0, fr, fq, rs8);
        if (pn < 8) {
            bf16_t* dst = pn < 4 ? qc : kc; const float sc = pn < 4 ? 0.125f * LOG2E : 1.f;
#pragma unroll
            for (int ai = 0; ai < 2; ++ai)
#pragma unroll
                for (int m = 0; m < 4; ++m) { const int row = row0 + ai * 128 + m * 16; const float rsc = rs8[ai][m] * sc;
#pragma unroll
                    for (int bj = 0; bj < 2; ++bj)
                        *(u32x4*)(dst + (size_t)row * 1024 + (pn & 3) * 256 + bj * 128 + wc * 32 + 8 * fq) = pk8(acc[ai][bj][m][0] * rsc, acc[ai][bj][m][1] * rsc); }
        } else {
#pragma unroll
            for (int ai = 0; ai < 2; ++ai)
#pragma unroll
                for (int m = 0; m < 4; ++m) { const int row = row0 + ai * 128 + m * 16; const float rs = rs8[ai][m];
#pragma unroll
                    for (int bj = 0; bj < 2; ++bj)
                        *(u32x4*)(vct + (size_t)row * 1024 + (pn - 8) * 256 + bj * 128 + wc * 32 + 8 * fq) = pk8(acc[ai][bj][m][0] * rs, acc[ai][bj][m][1] * rs); }
        }
    }
};

enum { MAP_IDENT = 0, MAP_EVIN, MAP_QUP, MAP_KVUP, MAP_ODQKV, MAP_GU, MAP_P32 };
__device__ __forceinline__ int p32(int w) { return (w & ~31) + pg8::perm32(w & 31); }
__device__ __forceinline__ int src_col(int map, int c, int sel) {
    switch (map) {
    case MAP_EVIN: { const int pn = c >> 8, w = c & 255;
        if (pn < 4) { const int bj = w >> 7, wc = (w >> 5) & 3, d = pg8::perm32(w & 31) + 32 * bj, head = 4 * (pn & 1) + wc; return 416 + (pn >> 1) * 512 + head * 64 + d; }
        if (pn < 6) return 416 + 1024 + (pn - 4) * 256 + p32(w);
        if (pn == 6) return p32(w);
        if (w < 128) return 256 + p32(w);
        if (w < 160) return 384 + (w - 128);
        return -1; }
    case MAP_QUP: { const int G = c >> 5, head = G / 3, part = G - 3 * head, rho = c & 31; return part < 2 ? head * 96 + 32 * part + pg8::perm32(rho) : head * 96 + 64 + rho; }
    case MAP_KVUP: { const int G = c >> 5, head = G >> 2, part = G & 3, rho = c & 31; return head * 128 + 32 * part + pg8::perm32(rho); }
    case MAP_ODQKV: { const int which = c >> 10, f = c & 1023; return which * 1024 + p32(f); }
    case MAP_GU: { const int pn = c >> 8, bj = (c >> 7) & 1, w = c & 127; if (bj != sel) return -2; return 128 * pn + p32(w); }
    case MAP_P32: return p32(c);
    default: return c;
    }
}
__device__ __forceinline__ void prep_w(float* tl, const float* __restrict__ W, int Nsrc, int Ksrc, const float* __restrict__ gain, bf16_t* Bt, int Kt, int klo, int row0, int nrows, int map, int sel) {
    const int tid = threadIdx.x, nkt = Kt >> 7, ntile = (nrows >> 6) * nkt;
    for (int t = blockIdx.x; t < ntile; t += gridDim.x) {
        const int tr = t / nkt, tk = t - tr * nkt;
        if (map == MAP_GU && src_col(map, tr * 64, sel) == -2) continue;
        { const int c = tid & 63, kq = tid >> 6, src = src_col(map, tr * 64 + c, sel);
          float v[16];
#pragma unroll
          for (int i = 0; i < 16; ++i) { const int ks = tk * 128 + kq * 16 + i - klo; v[i] = 0.f;
              if (src >= 0 && ks >= 0 && ks < Ksrc) v[i] = W[(size_t)ks * Nsrc + src]; }
          if (gain) {
#pragma unroll
              for (int i = 0; i < 16; ++i) { const int ks = tk * 128 + kq * 16 + i - klo; if (src >= 0 && ks >= 0 && ks < Ksrc) v[i] *= gain[ks]; } }
#pragma unroll
          for (int i = 0; i < 16; ++i) tl[(kq * 16 + i) * 65 + c] = v[i]; }
        __syncthreads();
#pragma unroll
        for (int half = 0; half < 2; ++half) { const int kc = tid & 15, c = (tid >> 4) + 32 * half; float v[8];
#pragma unroll
          for (int i = 0; i < 8; ++i) v[i] = tl[(kc * 8 + i) * 65 + c];
          u32x4 o; o.x = cvt_pk_bf16(v[0], v[1]); o.y = cvt_pk_bf16(v[2], v[3]); o.z = cvt_pk_bf16(v[4], v[5]); o.w = cvt_pk_bf16(v[6], v[7]);
          *(u32x4*)(Bt + (size_t)(row0 + tr * 64 + c) * Kt + tk * 128 + kc * 8) = o; }
        __syncthreads();
    }
}

__device__ __forceinline__ void norm_phase(const float* __restrict__ h, bf16_t* xn, float* outf, const float* __restrict__ g, float* ssq_out, int gw, int nw, int lane) {
    for (int row = gw; row < T_; row += nw) {
        const f32x4* p = (const f32x4*)(h + (size_t)row * 1024);
        f32x4 v[4]; float ss = 0.f;
#pragma unroll
        for (int i = 0; i < 4; ++i) { v[i] = p[lane + 64 * i]; ss += v[i][0] * v[i][0] + v[i][1] * v[i][1] + v[i][2] * v[i][2] + v[i][3] * v[i][3]; }
#pragma unroll
        for (int o = 32; o >= 1; o >>= 1) ss += xshfl(ss, lane, o);
        const float rs = rsqrtf(ss * (1.f / 1024.f) + EPSV);
        if (outf) {
#pragma unroll
            for (int i = 0; i < 4; ++i) { const f32x4 gg = *(const f32x4*)(g + 4 * (lane + 64 * i)); *(f32x4*)(outf + (size_t)row * 1024 + 4 * (lane + 64 * i)) = v[i] * rs * gg; }
        } else {
#pragma unroll
            for (int i = 0; i < 4; ++i) *(u32x2*)(xn + (size_t)row * 1024 + 4 * (lane + 64 * i)) = pk4(v[i]);
            if (lane < 16) ssq_out[row * 16 + lane] = lane == 0 ? ss : 0.f;
        }
    }
}

__device__ __forceinline__ void final_norm_phase(const bf16_t* __restrict__ xn, float* outf, const float* __restrict__ g, int gw, int nw, int lane) {
    for (int row = gw; row < T_; row += nw) {
        const u32x4* p = (const u32x4*)(xn + (size_t)row * 1024);
        f32x4 v[4]; float ss = 0.f;
#pragma unroll
        for (int i = 0; i < 2; ++i) { const u32x4 t = p[lane + 64 * i];
            v[2 * i][0] = __uint_as_float(t.x << 16); v[2 * i][1] = __uint_as_float(t.x & 0xffff0000u); v[2 * i][2] = __uint_as_float(t.y << 16); v[2 * i][3] = __uint_as_float(t.y & 0xffff0000u);
            v[2 * i + 1][0] = __uint_as_float(t.z << 16); v[2 * i + 1][1] = __uint_as_float(t.z & 0xffff0000u); v[2 * i + 1][2] = __uint_as_float(t.w << 16); v[2 * i + 1][3] = __uint_as_float(t.w & 0xffff0000u); }
#pragma unroll
        for (int i = 0; i < 4; ++i) ss += v[i][0] * v[i][0] + v[i][1] * v[i][1] + v[i][2] * v[i][2] + v[i][3] * v[i][3];
#pragma unroll
        for (int o = 32; o >= 1; o >>= 1) ss += xshfl(ss, lane, o);
        const float rs = rsqrtf(ss * (1.f / 1024.f) + EPSV);
#pragma unroll
        for (int i = 0; i < 2; ++i) { const int c0 = 8 * (lane + 64 * i);
            *(f32x4*)(outf + (size_t)row * 1024 + c0) = v[2 * i] * rs * *(const f32x4*)(g + c0);
            *(f32x4*)(outf + (size_t)row * 1024 + c0 + 4) = v[2 * i + 1] * rs * *(const f32x4*)(g + c0 + 4); }
    }
}

#define MFMA32(a, b, c) __builtin_amdgcn_mfma_f32_32x32x16_bf16(a, b, c, 0, 0, 0)
__device__ __forceinline__ bf16x8 mk8(u32x2 a, u32x2 b) { u32x4 t; t.x = a.x; t.y = a.y; t.z = b.x; t.w = b.y; return __builtin_bit_cast(bf16x8, t); }
typedef float f32x8v __attribute__((ext_vector_type(8)));
typedef float f32x2v __attribute__((ext_vector_type(2)));
__device__ __forceinline__ void softmax_pv(const f32x16& s, f32x16& o0, f32x16& o1, float& m, float& l, const bf16x8 v00, const bf16x8 v01, const bf16x8 v10, const bf16x8 v11, int lane, bool& fresh) {
    if (fresh) {
        float mx = s[0];
#pragma unroll
        for (int i = 1; i < 16; ++i) mx = fmaxf(mx, s[i]);
        mx = fmaxf(mx, xshfl(mx, lane, 32));
        m = fmaxf(mx, -16.f);
        fresh = false;
    }
    const f32x16 t = s - m;
    f32x16 p;
#pragma unroll
    for (int i = 0; i < 16; ++i) p[i] = fexp2(t[i]);
    const f32x8v a8 = p.lo + p.hi; const f32x4 a4 = a8.lo + a8.hi; const f32x2v a2 = a4.lo + a4.hi;
    l += a2.x + a2.y;
    u32x4 a, b;
    a.x = cvt_pk_bf16(p[0], p[1]); a.y = cvt_pk_bf16(p[2], p[3]); a.z = cvt_pk_bf16(p[4], p[5]); a.w = cvt_pk_bf16(p[6], p[7]);
    b.x = cvt_pk_bf16(p[8], p[9]); b.y = cvt_pk_bf16(p[10], p[11]); b.z = cvt_pk_bf16(p[12], p[13]); b.w = cvt_pk_bf16(p[14], p[15]);
    const bf16x8 pk0 = __builtin_bit_cast(bf16x8, a), pk1 = __builtin_bit_cast(bf16x8, b);
    o0 = MFMA32(v00, pk0, o0); o0 = MFMA32(v01, pk1, o0);
    o1 = MFMA32(v10, pk0, o1); o1 = MFMA32(v11, pk1, o1);
}
__device__ __forceinline__ void attn_store(int lane, const f32x16& o0, const f32x16& o1, float l, bf16_t* op  ) {
    const float inv = 1.f / (l + xshfl(l, lane, 32));
#pragma unroll
    for (int g = 0; g < 4; ++g) {
        u32x2 a, b;
        a.x = cvt_pk_bf16(o0[4 * g] * inv, o0[4 * g + 1] * inv); a.y = cvt_pk_bf16(o0[4 * g + 2] * inv, o0[4 * g + 3] * inv);
        b.x = cvt_pk_bf16(o1[4 * g] * inv, o1[4 * g + 1] * inv); b.y = cvt_pk_bf16(o1[4 * g + 2] * inv, o1[4 * g + 3] * inv);
        *(u32x2*)(op + 8 * g) = a; *(u32x2*)(op + 32 + 8 * g) = b;
    }
}
__device__ __forceinline__ void load_vt(const bf16_t* vrow, bf16x8& v00, bf16x8& v01, bf16x8& v10, bf16x8& v11) {
    v00 = mk8(*(const u32x2*)(vrow), *(const u32x2*)(vrow + 8)); v01 = mk8(*(const u32x2*)(vrow + 16), *(const u32x2*)(vrow + 24));
    const bf16_t* v1 = vrow + 32 * 2048;
    v10 = mk8(*(const u32x2*)(v1), *(const u32x2*)(v1 + 8)); v11 = mk8(*(const u32x2*)(v1 + 16), *(const u32x2*)(v1 + 24));
}

#define LASP PG8_LAS unsigned char*
__device__ __forceinline__ void read_vtr(LASP vimg, int keyoff, int lane, bf16x8& v00, bf16x8& v01, bf16x8& v10, bf16x8& v11) {
    LASP base = vimg + (keyoff + 4 * (lane >> 5) + ((lane & 15) >> 2)) * 144 + (16 * ((lane >> 4) & 1) + 4 * (lane & 3)) * 2;
    bf16x8 f[2][2];
#pragma unroll
    for (int dt = 0; dt < 2; ++dt)
#pragma unroll
        for (int s = 0; s < 2; ++s) {
            const s16x4 lo = __builtin_amdgcn_ds_read_tr16_b64_v4i16((PG8_LAS s16x4*)(base + (16 * s) * 144 + 64 * dt));
            const s16x4 hi = __builtin_amdgcn_ds_read_tr16_b64_v4i16((PG8_LAS s16x4*)(base + (16 * s + 8) * 144 + 64 * dt));
            bf16x8 g; g[0] = lo[0]; g[1] = lo[1]; g[2] = lo[2]; g[3] = lo[3]; g[4] = hi[0]; g[5] = hi[1]; g[6] = hi[2]; g[7] = hi[3]; f[dt][s] = g; }
    v00 = f[0][0]; v01 = f[0][1]; v10 = f[1][0]; v11 = f[1][1];
}
template <int KD> struct StageCfg { static constexpr int KP = KD * 2 + 16, KBYTES = 64 * KP, VP = 136, VBYTES = 64 * VP, BYTES = KBYTES + VBYTES; };
struct StageRegs { u32x4 k, v, pe; };
template <int KD>
__device__ __forceinline__ void stage_issue(StageRegs& R, const bf16_t* __restrict__ krow0, int kstride, const bf16_t* __restrict__ pe0, const bf16_t* __restrict__ vt0, int tid) {
    R.k = *(const u32x4*)(krow0 + (size_t)(tid >> 3) * kstride + (tid & 7) * 8);
    R.v = *(const u32x4*)(vt0 + (size_t)(tid >> 3) * 2048 + (tid & 7) * 8);
    if (KD == 96) R.pe = *(const u32x4*)(pe0 + ((tid >> 2) & 63) * 32 + (tid & 3) * 8);
}
template <int KD>
__device__ __forceinline__ void stage_commit(LASP buf, const StageRegs& R, int tid) {
    typedef StageCfg<KD> C;
    *(PG8_LAS u32x4*)(buf + (tid >> 3) * C::KP + (tid & 7) * 16) = R.k;
    LASP vp = buf + C::KBYTES + (tid >> 3) * C::VP + (tid & 7) * 16;
    u32x2 a, b; a.x = R.v.x; a.y = R.v.y; b.x = R.v.z; b.y = R.v.w;
    *(PG8_LAS u32x2*)vp = a; *(PG8_LAS u32x2*)(vp + 8) = b;
    if (KD == 96) { if (tid < 256) *(PG8_LAS u32x4*)(buf + (tid >> 2) * C::KP + 128 + (tid & 3) * 16) = R.pe; }
}
template <int KD>
__device__ __forceinline__ void read_kf(LASP buf, int row, int h, bf16x8 (&kf)[KD / 16]) {
#pragma unroll
    for (int kk = 0; kk < KD / 16; ++kk) kf[kk] = *(const PG8_LAS bf16x8*)(buf + row * StageCfg<KD>::KP + 32 * kk + 16 * h);
}
__device__ __forceinline__ void read_vf(LASP vbuf, int r, int keyoff, bf16x8& v00, bf16x8& v01, bf16x8& v10, bf16x8& v11) {
    LASP p0 = vbuf + r * 136 + keyoff * 2; LASP p1 = p0 + 32 * 136;
    v00 = mk8(*(const PG8_LAS u32x2*)(p0), *(const PG8_LAS u32x2*)(p0 + 16)); v01 = mk8(*(const PG8_LAS u32x2*)(p0 + 32), *(const PG8_LAS u32x2*)(p0 + 48));
    v10 = mk8(*(const PG8_LAS u32x2*)(p1), *(const PG8_LAS u32x2*)(p1 + 16)); v11 = mk8(*(const PG8_LAS u32x2*)(p1 + 32), *(const PG8_LAS u32x2*)(p1 + 48));
}


template <int KD, int PD, bool ALWAYS, class Src, class Comp>
__device__ __forceinline__ void staged_loop(LASP lds, int s_lo, int s_hi, int tid, Src&& src, Comp&& comp) {
    typedef StageCfg<KD> C;
    if (s_lo >= s_hi) return;
    StageRegs R[PD];
    src(s_lo, R[0]); stage_commit<KD>(lds + (s_lo & 1) * C::BYTES, R[0], tid);
#pragma unroll
    for (int d = 1; d < PD; ++d) { if (ALWAYS) src(s_lo + d < s_hi ? s_lo + d : s_hi - 1, R[d]); else if (s_lo + d < s_hi) src(s_lo + d, R[d]); }
    __syncthreads();
    for (int st = s_lo; st < s_hi; st += PD) {
#pragma unroll
        for (int d = 0; d < PD; ++d) {
            const int s = st + d;
            if (s < s_hi) {
                if (ALWAYS) src(s + PD < s_hi ? s + PD : s_hi - 1, R[d]); else if (s + PD < s_hi) src(s + PD, R[d]);
                comp(s, lds + (s & 1) * C::BYTES);
                if (s + 1 < s_hi) stage_commit<KD>(lds + ((s + 1) & 1) * C::BYTES, R[(d + 1) % PD], tid);
                __syncthreads();
            }
        }
    }
}

__device__ __forceinline__ void mla_phase(LASP lds, const bf16_t* __restrict__ QA, const bf16_t* __restrict__ KA, const bf16_t* __restrict__ KPE, const bf16_t* __restrict__ VAT, bf16_t* O, int tid) {
    constexpr int KB_ = 64 * 208, SB = KB_ + 64 * 144 + 2 * 1024;
    const int lane = tid & 63, w = __builtin_amdgcn_readfirstlane(tid >> 6), r = lane & 31, h = lane >> 5;
    if (w >= 4) __builtin_amdgcn_s_setprio(1);
    for (int it = blockIdx.x; it < 1024; it += gridDim.x) {
        int item = it;
        if (gridDim.x == 256) { const int k = it >> 8, B = it & 255, x = B & 7, y = B >> 3; item = ((((k * 8 + x) * 4) + (y >> 3)) << 3) | (y & 7); }
        const int bh = item >> 3, qb8 = item & 7, b = bh >> 3, head = bh & 7;
        const size_t tq = (size_t)b * 2048 + qb8 * 256 + w * 32 + r;
        bf16x8 qf[6];
#pragma unroll
        for (int kk = 0; kk < 6; ++kk) qf[kk] = *(const bf16x8*)(QA + tq * 768 + head * 96 + 16 * kk + 8 * h);
        const char* src[3]; unsigned step[3]; int dst[3];
#pragma unroll
        for (int j = 0; j < 3; ++j) {
            const int p = w + 8 * j;
            if (p < 13) { const int c = 64 * p + lane, row = c / 13, col = c - 13 * row;
                if (col >= 8 && col < 12) { src[j] = (const char*)(KPE + ((size_t)b * 2048 + row) * 32 + (col - 8) * 8); step[j] = 64 * 32 * 2; }
                else { src[j] = (const char*)(KA + ((size_t)b * 2048 + row) * 512 + head * 64 + (col & 7) * 8); step[j] = 64 * 512 * 2; }
                dst[j] = p * 1024; }
            else if (p < 22) { const int c = 64 * (p - 13) + lane, row = c / 9, col = c - 9 * row;
                src[j] = (const char*)(VAT + ((size_t)b * 2048 + row) * 512 + head * 64 + (col & 7) * 8); step[j] = 64 * 512 * 2; dst[j] = KB_ + (p - 13) * 1024; }
            else { src[j] = (const char*)(KA + ((size_t)b * 2048 + lane) * 512); step[j] = 0; dst[j] = KB_ + 64 * 144 + (p - 22) * 1024; }
        }
        f32x16 o0, o1;
#pragma unroll
        for (int i = 0; i < 16; ++i) { o0[i] = 0.f; o1[i] = 0.f; }
        float m = 0.f, l = 0.f; bool fresh = true;
#define MLA_ISSUE(st) do { const int _s = (st) < 32 ? (st) : 31; LASP _b = lds + ((st) % 5) * SB; _Pragma("unroll") for (int _j = 0; _j < 3; ++_j) \
        __builtin_amdgcn_global_load_lds((const unsigned*)(src[_j] + (size_t)_s * step[_j]), (PG8_LAS unsigned*)(_b + dst[_j]), 16, 0, 0); } while (0)
        asm volatile("s_waitcnt vmcnt(0) lgkmcnt(0)" ::: "memory"); __builtin_amdgcn_s_barrier();
        MLA_ISSUE(0); MLA_ISSUE(1); MLA_ISSUE(2); MLA_ISSUE(3);
        for (int st = 0; st < 32; ++st) {
            asm volatile("s_waitcnt vmcnt(9)" ::: "memory");
            __builtin_amdgcn_s_barrier();
            asm volatile("" ::: "memory");
            MLA_ISSUE(st + 4);
            LASP buf = lds + (st % 5) * SB;
#pragma unroll
            for (int sub = 0; sub < 2; ++sub) {
                bf16x8 kf[6], v00, v01, v10, v11;
#pragma unroll
                for (int kk = 0; kk < 6; ++kk) kf[kk] = *(const PG8_LAS bf16x8*)(buf + (32 * sub + r) * 208 + 32 * kk + 16 * h);
                read_vtr(buf + KB_, 32 * sub, lane, v00, v01, v10, v11);
                __builtin_amdgcn_sched_barrier(0);
                f32x16 s;
#pragma unroll
                for (int i = 0; i < 16; ++i) s[i] = 0.f;
#pragma unroll
                for (int kk = 0; kk < 6; ++kk) s = MFMA32(kf[kk], qf[kk], s);
                softmax_pv(s, o0, o1, m, l, v00, v01, v10, v11, lane, fresh);
            }
        }
#undef MLA_ISSUE
        attn_store(lane, o0, o1, l, O + tq * 1024 + head * 64 + 4 * h);
    }
    __builtin_amdgcn_s_setprio(0);
    asm volatile("s_waitcnt vmcnt(0)" ::: "memory"); __syncthreads();
}


constexpr int D64_KB = 64 * 144, D64_SB = 2 * D64_KB + 1024;
template <int NBUF, class Comp>
__device__ __forceinline__ void dma64_loop(LASP lds, int s_lo, int s_hi, const bf16_t* kbase  , int kstride, const bf16_t* vbase  , int w, int lane, Comp&& comp) {
    const char* src[3]; unsigned step[3]; int dst[3];
#pragma unroll
    for (int j = 0; j < 3; ++j) {
        const int p = w + 8 * j;
        if (p < 9) { const int c = 64 * p + lane, row = c / 9, col = c - 9 * row; src[j] = (const char*)(kbase + (size_t)row * kstride + (col & 7) * 8); step[j] = (unsigned)(64 * kstride * 2); dst[j] = p * 1024; }
        else if (p < 18) { const int c = 64 * (p - 9) + lane, row = c / 9, col = c - 9 * row; src[j] = (const char*)(vbase + (size_t)row * kstride + (col & 7) * 8); step[j] = (unsigned)(64 * kstride * 2); dst[j] = D64_KB + (p - 9) * 1024; }
        else { src[j] = (const char*)(kbase + (size_t)lane * kstride); step[j] = 0u; dst[j] = 2 * D64_KB; }
    }
#define D64_ISSUE(st) do { const int _s = (st) < s_hi ? (st) : s_hi - 1; LASP _b = lds + (((st) - s_lo) % NBUF) * D64_SB; _Pragma("unroll") for (int _j = 0; _j < 3; ++_j) \
        __builtin_amdgcn_global_load_lds((const unsigned*)(src[_j] + (size_t)_s * step[_j]), (PG8_LAS unsigned*)(_b + dst[_j]), 16, 0, 0); } while (0)
    asm volatile("s_waitcnt vmcnt(0) lgkmcnt(0)" ::: "memory"); __builtin_amdgcn_s_barrier();
#pragma unroll
    for (int d = 0; d < NBUF - 1; ++d) D64_ISSUE(s_lo + d);
    for (int st = s_lo; st < s_hi; ++st) {
        if (NBUF == 5) asm volatile("s_waitcnt vmcnt(9)" ::: "memory"); else if (NBUF == 4) asm volatile("s_waitcnt vmcnt(6)" ::: "memory"); else asm volatile("s_waitcnt vmcnt(3)" ::: "memory");
        __builtin_amdgcn_s_barrier();
        asm volatile("" ::: "memory");
        D64_ISSUE(st + NBUF - 1);
        comp(st, lds + ((st - s_lo) % NBUF) * D64_SB);
    }
#undef D64_ISSUE
    asm volatile("s_waitcnt vmcnt(0)" ::: "memory"); __builtin_amdgcn_s_barrier();
}
__device__ __forceinline__ void d64_read(LASP buf, int krow, int lane, int keyoff, int h, bf16x8 (&kf)[4], bf16x8& v00, bf16x8& v01, bf16x8& v10, bf16x8& v11) {
#pragma unroll
    for (int kk = 0; kk < 4; ++kk) kf[kk] = *(const PG8_LAS bf16x8*)(buf + krow * 144 + 32 * kk + 16 * h);
    read_vtr(buf + D64_KB, keyoff, lane, v00, v01, v10, v11);
}

__device__ __forceinline__ void dil_phase(LASP lds, const bf16_t* __restrict__ QB, const bf16_t* __restrict__ KB, const bf16_t* __restrict__ VBT, const bf16_t* __restrict__ VB, bf16_t* O, int tid) {
    typedef StageCfg<64> C;
    const int lane = tid & 63, w = tid >> 6, r = lane & 31, h = lane >> 5;
    LASP wsc = lds + 4 * D64_SB + w * 4608;
    if (__builtin_amdgcn_readfirstlane(tid >> 6) >= 4) __builtin_amdgcn_s_setprio(1);
    for (int it = blockIdx.x; it < 1024; it += gridDim.x) {
        int item = it;
        if (gridDim.x == 256) { const int k = it >> 8, B = it & 255, x = B & 7, y = B >> 3; item = ((((k * 8 + x) * 4) + (y >> 3)) << 3) | (y & 7); }
        const int bh = item >> 3, a = (item >> 1) & 3, rr = 8 * (item & 1) + w, b = bh >> 3, head = bh & 7;
        const int tq = 512 * a + rr + 16 * r;
        bf16x8 qf[4];
#pragma unroll
        for (int kk = 0; kk < 4; ++kk) qf[kk] = *(const bf16x8*)(QB + ((size_t)b * 2048 + tq) * 512 + head * 64 + 16 * kk + 8 * h);
        f32x16 o0, o1;
#pragma unroll
        for (int i = 0; i < 16; ++i) { o0[i] = 0.f; o1[i] = 0.f; }
        float m = 0.f, l = 0.f; bool fresh = true;
        {
            const int s_lo = a == 0 ? 1 : 0, s_hi = a == 3 ? 9 : 10;
            const bf16_t* k0 = KB + ((size_t)b * 2048 + 512 * a - 64) * 512 + head * 64;
            const bf16_t* vt0 = VB + ((size_t)b * 2048 + 512 * a - 64) * 512 + head * 64;
            dma64_loop<4>(lds, s_lo, s_hi, k0, 512, vt0, __builtin_amdgcn_readfirstlane(w), lane, [&](int st, LASP buf) {
#pragma unroll
                for (int sub = 0; sub < 2; ++sub) {
                    bf16x8 kf[4], v00, v01, v10, v11;
                    d64_read(buf, 32 * sub + r, lane, 32 * sub, h, kf, v00, v01, v10, v11);
                    f32x16 s;
#pragma unroll
                    for (int i = 0; i < 16; ++i) s[i] = 0.f;
#pragma unroll
                    for (int kk = 0; kk < 4; ++kk) s = MFMA32(kf[kk], qf[kk], s);
                    const int base = 512 * a - 64 + 64 * st + 32 * sub + 4 * h - tq;
#pragma unroll
                    for (int i = 0; i < 16; ++i) { const int dd = base + 8 * (i >> 2) + (i & 3); s[i] = (dd <= 64 && dd >= -64) ? s[i] : -__builtin_inff(); }
                    softmax_pv(s, o0, o1, m, l, v00, v01, v10, v11, lane, fresh);
                }
            });
        }
        {
            const bf16_t* kb = KB + (size_t)b * 2048 * 512 + head * 64 + 8 * h;
            const bf16_t* vb = VB + (size_t)b * 2048 * 512 + head * 64 + 8 * h;
            auto tile_ok = [&](int t) -> bool { const int u0 = t < 8 ? 128 * a - 64 + 32 * t : 32 * a - 64 + 32 * (t - 8); return u0 >= 0 && u0 < (t < 8 ? 512 : 128); };
            auto tile_pos = [&](int t) -> int { return t < 8 ? 4 * (128 * a - 64 + 32 * t + r) + (rr & 3) : 16 * (32 * a - 64 + 32 * (t - 8) + r) + rr; };
            int t = 0; while (t < 13 && !tile_ok(t)) ++t;
            u32x4 kc[4], vc[4];
            if (t < 13) { const size_t kp = (size_t)tile_pos(t) * 512;
#pragma unroll
                for (int kk = 0; kk < 4; ++kk) { kc[kk] = *(const u32x4*)(kb + kp + 16 * kk); vc[kk] = *(const u32x4*)(vb + kp + 16 * kk); } }
            while (t < 13) {
                int tn = t + 1; while (tn < 13 && !tile_ok(tn)) ++tn;
                u32x4 kn[4], vn[4];
                if (tn < 13) { const size_t kp = (size_t)tile_pos(tn) * 512;
#pragma unroll
                    for (int kk = 0; kk < 4; ++kk) { kn[kk] = *(const u32x4*)(kb + kp + 16 * kk); vn[kk] = *(const u32x4*)(vb + kp + 16 * kk); } }
#pragma unroll
                for (int kk = 0; kk < 4; ++kk) *(PG8_LAS u32x4*)(wsc + r * 144 + 32 * kk + 16 * h) = vc[kk];
                __builtin_amdgcn_wave_barrier();
                f32x16 s;
#pragma unroll
                for (int i = 0; i < 16; ++i) s[i] = 0.f;
#pragma unroll
                for (int kk = 0; kk < 4; ++kk) s = MFMA32(__builtin_bit_cast(bf16x8, kc[kk]), qf[kk], s);
                bf16x8 vv[2][2];
#pragma unroll
                for (int dt = 0; dt < 2; ++dt)
#pragma unroll
                    for (int sx = 0; sx < 2; ++sx) {
                        const s16x4 lo = __builtin_amdgcn_ds_read_tr16_b64_v4i16((PG8_LAS s16x4*)(wsc + (16 * sx + 4 * h + ((lane & 15) >> 2)) * 144 + (32 * dt + 16 * ((lane >> 4) & 1) + 4 * (lane & 3)) * 2));
                        const s16x4 hi = __builtin_amdgcn_ds_read_tr16_b64_v4i16((PG8_LAS s16x4*)(wsc + (16 * sx + 8 + 4 * h + ((lane & 15) >> 2)) * 144 + (32 * dt + 16 * ((lane >> 4) & 1) + 4 * (lane & 3)) * 2));
                        bf16x8 f; f[0] = lo[0]; f[1] = lo[1]; f[2] = lo[2]; f[3] = lo[3]; f[4] = hi[0]; f[5] = hi[1]; f[6] = hi[2]; f[7] = hi[3];
                        vv[dt][sx] = f; }
                __builtin_amdgcn_wave_barrier();
                const int base = (t < 8 ? 128 * a - 64 + 32 * t - (128 * a + (rr >> 2) + 4 * r) : 32 * a - 64 + 32 * (t - 8) - (32 * a + r)) + 4 * h;
#pragma unroll
                for (int i = 0; i < 16; ++i) { const int dd = base + 8 * (i >> 2) + (i & 3); s[i] = (dd <= 64 && dd >= -64) ? s[i] : -__builtin_inff(); }
                softmax_pv(s, o0, o1, m, l, vv[0][0], vv[0][1], vv[1][0], vv[1][1], lane, fresh);
#pragma unroll
                for (int kk = 0; kk < 4; ++kk) { kc[kk] = kn[kk]; vc[kk] = vn[kk]; }
                t = tn;
            }
        }
        attn_store(lane, o0, o1, l, O + ((size_t)b * 2048 + tq) * 1024 + 512 + head * 64 + 4 * h);
        __syncthreads();
    }
    __builtin_amdgcn_s_setprio(0);
}

__device__ __forceinline__ int clampi(int v, int lo, int hi) { return v < lo ? lo : (v > hi ? hi : v); }
__device__ __forceinline__ void na_phase(LASP lds, const bf16_t* __restrict__ QC, const bf16_t* __restrict__ KC, const bf16_t* __restrict__ VCT, const float* __restrict__ rpb, bf16_t* O, int tid) {
    typedef StageCfg<64> C;
    const int lane = tid & 63, w = tid >> 6, r = lane & 31, h = lane >> 5;
    PG8_LAS float* btab = (PG8_LAS float*)(lds + 5 * D64_SB + 256);
    if (__builtin_amdgcn_readfirstlane(tid >> 6) >= 4) __builtin_amdgcn_s_setprio(1);
    for (int it = blockIdx.x; it < 2048; it += gridDim.x) {
        int item = it;
        if (gridDim.x == 256) { const int k = it >> 8, B = it & 255, x = B & 7, y = B >> 3; item = ((((k * 8 + x) * 4) + (y >> 3)) << 3) | (y & 7); }
        const int bh = item >> 3, rg = item & 7, b = bh >> 4, head = bh & 15;
        const int rp = 2 * rg + (w >> 2), j = w & 3;
        const int qrow = 2 * rp + (r >> 4), qcol = 16 * j + (r & 15), tq = qrow * 64 + qcol;
        bf16x8 qf[4];
#pragma unroll
        for (int kk = 0; kk < 4; ++kk) qf[kk] = *(const bf16x8*)(QC + ((size_t)b * 2048 + tq) * 1024 + head * 64 + 16 * kk + 8 * h);
        const int rs_q = clampi(qrow - 4, 0, 24), cs_q = clampi(qcol - 8, 0, 48), band = clampi(16 * j - 8, 0, 32);
        const int kr_lo = clampi(4 * rg - 4, 0, 24), nst = clampi(4 * rg - 1, 0, 24) + 8 - kr_lo;
        const int wlo = clampi(2 * rp - 4, 0, 24), whi = clampi(2 * rp - 3, 0, 24) + 8;
        const int cbase = band + 4 * h - qcol + 15;
        float cadd[16];
#pragma unroll
        for (int i = 0; i < 16; ++i) { const int kc = band + 8 * (i >> 2) + 4 * h + (i & 3); cadd[i] = (kc >= cs_q && kc < cs_q + 16) ? 0.f : -__builtin_inff(); }
        const bf16_t* k0 = KC + ((size_t)b * 2048 + kr_lo * 64) * 1024 + head * 64;
        const bf16_t* vt0 = VCT + ((size_t)b * 2048 + kr_lo * 64) * 1024 + head * 64;
        f32x16 o0, o1;
#pragma unroll
        for (int i = 0; i < 16; ++i) { o0[i] = 0.f; o1[i] = 0.f; }
        float m = 0.f, l = 0.f; bool fresh = true;
        asm volatile("s_waitcnt lgkmcnt(0)" ::: "memory"); __builtin_amdgcn_s_barrier();
        btab[tid] = tid < 465 ? rpb[head * 465 + tid] * LOG2E : 0.f;
        if (tid < 16) btab[tid - 16] = 0.f;
        dma64_loop<5>(lds, 0, nst, k0, 1024, vt0, __builtin_amdgcn_readfirstlane(w), lane, [&](int st, LASP buf) {
            const int kr = kr_lo + st;
            if (kr >= wlo && kr < whi) {
                bf16x8 kf[4], v00, v01, v10, v11;
                d64_read(buf, band + r, lane, band, h, kf, v00, v01, v10, v11);
                f32x16 s;
#pragma unroll
                for (int i = 0; i < 16; ++i) s[i] = 0.f;
#pragma unroll
                for (int kk = 0; kk < 4; ++kk) s = MFMA32(kf[kk], qf[kk], s);
                const float radd = ((kr >= rs_q) && (kr < rs_q + 8)) ? 0.f : -__builtin_inff();
                const PG8_LAS float* bp = btab + clampi(kr - qrow + 7, 0, 14) * 31 + cbase;
#pragma unroll
                for (int i = 0; i < 16; ++i) s[i] = s[i] + (bp[8 * (i >> 2) + (i & 3)] + cadd[i]) + radd;
                softmax_pv(s, o0, o1, m, l, v00, v01, v10, v11, lane, fresh);
            }
        });
        attn_store(lane, o0, o1, l, O + ((size_t)b * 2048 + tq) * 1024 + head * 64 + 4 * h);
    }
    __builtin_amdgcn_s_setprio(0);
}

__device__ __forceinline__ int my_tid(int wid_s) { unsigned z = 0u; asm volatile("" : "+s"(z)); return wid_s * 64 + (int)__builtin_amdgcn_mbcnt_hi(~0u, __builtin_amdgcn_mbcnt_lo(~0u, z)); }
__global__ void __launch_bounds__(512, 2) fwd_kernel(Params p) {
    extern __shared__ __attribute__((aligned(16))) unsigned char shm[];
    cg::grid_group grid = cg::this_grid();
    PG8_LAS unsigned char* lds = (PG8_LAS unsigned char*)shm;
    const int tid = threadIdx.x, lane = tid & 63, wid = tid >> 6;
    const int wid_s = __builtin_amdgcn_readfirstlane(wid);
    const unsigned xcc = xb_xcc_id();
    if (tid < 4) ((volatile PG8_LAS unsigned*)(lds + pg8::STAGE_BYTES))[tid] = 0u;
    if (tid == 0) (void)xb_add((unsigned*)(p.ws + WS_BAR) + XB_XCNT(xcc), 1u);
    __syncthreads();
    const int gw = blockIdx.x * 8 + wid, nw = gridDim.x * 8;

    for (int rep0 = 0; rep0 < NREP(10); ++rep0)
    {
        unsigned char* ws = p.ws; float* cosA = (float*)(ws + WS_COSA); float* sinA = (float*)(ws + WS_SINA); float* cosB = (float*)(ws + WS_COSB); float* sinB = (float*)(ws + WS_SINB); bf16_t* XN = (bf16_t*)(ws + WS_XN);
        float* tl = (float*)shm;
        for (int i = 0; i < 2; ++i) {
            prep_w(tl, p.in[2] + (size_t)i * 1024 * 1952, 1952, 1024, p.in[1] + i * 1024, (bf16_t*)(ws + W_IN + i * SZ_IN), 1024, 0, 0, 2048, MAP_EVIN, 0);
            prep_w(tl, p.in[4] + (size_t)i * 256 * 768, 768, 256, p.in[3] + i * 256, (bf16_t*)(ws + W_UP + i * SZ_UP), 384, 0, 0, 768, MAP_QUP, 0);
            prep_w(tl, p.in[6] + (size_t)i * 128 * 1024, 1024, 128, p.in[5] + i * 128, (bf16_t*)(ws + W_UP + i * SZ_UP), 384, 256, 768, 1024, MAP_KVUP, 0);
            prep_w(tl, p.in[7] + (size_t)i * 1024 * 1024, 1024, 1024, nullptr, (bf16_t*)(ws + W_EOUT + i * SZ_EOUT), 1024, 0, 0, 1024, MAP_P32, 0);
            prep_w(tl, p.in[9] + (size_t)i * 1024 * 3072, 3072, 1024, p.in[8] + i * 1024, (bf16_t*)(ws + W_QKV + i * SZ_QKV), 1024, 0, 0, 3072, MAP_ODQKV, 0);
            prep_w(tl, p.in[11] + (size_t)i * 1024 * 1024, 1024, 1024, nullptr, (bf16_t*)(ws + W_OOUT + i * SZ_OOUT), 1024, 0, 0, 1024, MAP_P32, 0);
        }
        for (int L = 0; L < 4; ++L) {
            prep_w(tl, p.in[13] + (size_t)L * 1024 * 2816, 2816, 1024, p.in[12] + L * 1024, (bf16_t*)(ws + W_GU + L * SZ_GU), 1024, 0, 0, 5632, MAP_GU, 0);
            prep_w(tl, p.in[14] + (size_t)L * 1024 * 2816, 2816, 1024, p.in[12] + L * 1024, (bf16_t*)(ws + W_GU + L * SZ_GU), 1024, 0, 0, 5632, MAP_GU, 1);
            prep_w(tl, p.in[15] + (size_t)L * 2816 * 1024, 1024, 2816, nullptr, (bf16_t*)(ws + W_DN + L * SZ_DN), 2816, 0, 0, 1024, MAP_P32, 0);
        }
        for (int idx = blockIdx.x * 512 + tid; idx < 2048 * 32; idx += gridDim.x * 512) {
            const int pos = idx >> 5, i = idx & 31; const float inv = powf(10000.f, -(float)(2 * i) / 64.f), ang = (float)pos * inv;
            cosB[idx] = cosf(ang); sinB[idx] = sinf(ang);
            if (i < 16) { const float inva = powf(10000.f, -(float)(2 * i) / 32.f), anga = (float)pos * inva; cosA[pos * 16 + i] = cosf(anga); sinA[pos * 16 + i] = sinf(anga); }
        }
        float* nssq = (float*)(ws + WS_NSSQ);
        norm_phase(p.in[0], XN, nullptr, nullptr, nssq, gw, nw, lane);
    }
    grid.sync();

    for (int ph = 0; ph < 30 + EXTRA_N; ++ph) {
        const int lp = ph < 30 ? ph / 15 : 1, q = ph < 30 ? ph - 15 * lp : EXTRA_Q;
        __attribute__((address_space(1))) unsigned char* ws_g = (__attribute__((address_space(1))) unsigned char*)p.ws; asm volatile("" : "+s"(ws_g)); unsigned char* ws = (unsigned char*)ws_g;
        bf16_t* XN = (bf16_t*)(ws + WS_XN); bf16_t* O = (bf16_t*)(ws + WS_O); bf16_t* HFF = (bf16_t*)(ws + R_HFF);
        if (EN(0) && q == 0) {
            pg8::Gemm g{XN, (const bf16_t*)(ws + W_IN + lp * SZ_IN), T_, 2048, 1024};
            pg8::StaticOrder S; S.init(g.M, g.N, (int)gridDim.x, (int)blockIdx.x);
            EpiEvenIn E{ws, (const float*)(ws + WS_NSSQ)};
            pg8::gemm_phase<EpiEvenIn, pg8::StaticOrder, false>(lds, g, S, E, nullptr, my_tid(wid_s));
        } else if (EN(1) && q == 1) {
            pg8::Gemm g{(const bf16_t*)(ws + R_A2), (const bf16_t*)(ws + W_UP + lp * SZ_UP), T_, 1792, 384};
            pg8::StaticOrder S; S.init(g.M, g.N, (int)gridDim.x, (int)blockIdx.x);
            EpiEvenUp E{ws};
            pg8::gemm_phase<EpiEvenUp, pg8::StaticOrder, false>(lds, g, S, E, nullptr, my_tid(wid_s));
            dil_phase(lds, (const bf16_t*)(ws + R_QB), (const bf16_t*)(ws + R_KB), (const bf16_t*)(ws + R_VBT), (const bf16_t*)(ws + R_VB), O, my_tid(wid_s));
        } else if (EN(2) && q == 2) {
            const int t2 = my_tid(wid_s);
            { int nrep = NREP(8); asm volatile("" : "+s"(nrep)); for (int rep = 0; rep < nrep; ++rep)
                mla_phase(lds, (const bf16_t*)(ws + R_QA), (const bf16_t*)(ws + R_KA), (const bf16_t*)(ws + R_KPE), (const bf16_t*)(ws + R_VAT), O, t2); }
        } else if (EN(3) && (q == 3 || q == 6 || q == 10 || q == 13)) {
            const bool dn = (q == 6 || q == 13);
            const bf16_t* Bt = q == 3 ? (const bf16_t*)(ws + W_EOUT + lp * SZ_EOUT) : q == 10 ? (const bf16_t*)(ws + W_OOUT + lp * SZ_OOUT) : (const bf16_t*)(ws + W_DN + (2 * lp + (q == 13)) * SZ_DN);
            pg8::Gemm g{dn ? HFF : O, Bt, T_, 1024, dn ? 2816 : 1024};
            pg8::StaticOrder S; S.init(g.M, g.N, (int)gridDim.x, (int)blockIdx.x);
            EpiResid E{ph == 3 ? p.in[0] : nullptr, XN, (float*)(ws + WS_NSSQ)};
            pg8::gemm_phase<EpiResid, pg8::StaticOrder, false>(lds, g, S, E, nullptr, my_tid(wid_s));
        } else if (q == 4 || q == 7 || q == 11 || q == 14) {
            if (ph != 29) continue;
            const int t2 = my_tid(wid_s), lane = t2 & 63, gw = blockIdx.x * 8 + (t2 >> 6);
            final_norm_phase(XN, p.out, p.in[16], gw, nw, lane);
        } else if (EN(5) && (q == 5 || q == 12)) {
            pg8::Gemm g{XN, (const bf16_t*)(ws + W_GU + (2 * lp + (q == 12)) * SZ_GU), T_, 5632, 1024};
            pg8::StaticOrder S; S.init(g.M, g.N, (int)gridDim.x, (int)blockIdx.x);
            EpiGateUp E{HFF, (const float*)(ws + WS_NSSQ)};
            pg8::gemm_phase<EpiGateUp, pg8::StaticOrder, false>(lds, g, S, E, nullptr, my_tid(wid_s));
        } else if (EN(6) && q == 8) {
            pg8::Gemm g{XN, (const bf16_t*)(ws + W_QKV + lp * SZ_QKV), T_, 3072, 1024};
            pg8::StaticOrder S; S.init(g.M, g.N, (int)gridDim.x, (int)blockIdx.x);
            EpiOddQKV E{ws, (const float*)(ws + WS_NSSQ)};
            pg8::gemm_phase<EpiOddQKV, pg8::StaticOrder, false>(lds, g, S, E, nullptr, my_tid(wid_s));
        } else if (EN(7) && q == 9) {
            const int t2 = my_tid(wid_s);
            int nrep = NREP(7); asm volatile("" : "+s"(nrep));
            for (int rep = 0; rep < nrep; ++rep) na_phase(lds, (const bf16_t*)(ws + R_QC), (const bf16_t*)(ws + R_KC), (const bf16_t*)(ws + R_VCT), p.in[10] + (size_t)lp * 16 * 465, O, t2);
        }
        if (ph != 29 + EXTRA_N) { int nrep = NREP(11); asm volatile("" : "+s"(nrep)); for (int rep = 0; rep < nrep; ++rep) xcd_barrier((unsigned*)(ws + WS_BAR), xcc, (volatile PG8_LAS unsigned*)(lds + pg8::STAGE_BYTES), my_tid(wid_s)); }
    }
}

extern "C" void kernel_launch(void* const* d_in, const int* in_sizes, int n_in, void* d_out, int out_size, void* d_ws, size_t ws_size, hipStream_t stream) {
    constexpr int LDS_BYTES = pg8::STAGE_BYTES + 16;
    static int grid = 0;
    if (grid == 0) {
        if (n_in != 17 || out_size != T_ * 1024 || ws_size < WS_END) { fprintf(stderr, "kernel_launch: unexpected shapes (n_in %d out %d ws %zu, need %zu)\n", n_in, out_size, ws_size, (size_t)WS_END); grid = -1; return; }
        int dev = 0, cus = 0, per_cu = 0;
        hipGetDevice(&dev);
        hipDeviceGetAttribute(&cus, hipDeviceAttributeMultiprocessorCount, dev);
        if (hipFuncSetAttribute((const void*)fwd_kernel, hipFuncAttributeMaxDynamicSharedMemorySize, LDS_BYTES) != hipSuccess) { fprintf(stderr, "kernel_launch: hipFuncSetAttribute failed\n"); grid = -1; return; }
        if (hipOccupancyMaxActiveBlocksPerMultiprocessor(&per_cu, (const void*)fwd_kernel, 512, LDS_BYTES) != hipSuccess || per_cu < 1) { fprintf(stderr, "kernel_launch: occupancy query says %d\n", per_cu); per_cu = 1; }
        (void)hipGetLastError();
        grid = cus * 1;
    }
    if (grid < 0) return;
    if (hipMemsetAsync((char*)d_ws + WS_BAR, 0, XCD_BAR_WORDS * sizeof(unsigned), stream) != hipSuccess) { fprintf(stderr, "kernel_launch: memset of the barrier words failed\n"); return; }
    Params p{};
    for (int i = 0; i < 17; ++i) p.in[i] = (const float*)d_in[i];
    p.out = (float*)d_out; p.ws = (unsigned char*)d_ws;
    void* args[] = {&p};
    hipError_t e = hipLaunchCooperativeKernel((const void*)fwd_kernel, dim3(grid), dim3(512), args, LDS_BYTES, stream);
    if (e != hipSuccess) fprintf(stderr, "cooperative launch failed: %s (grid %d)\n", hipGetErrorString(e), grid);
}
```

```cpp
#include <hip/hip_runtime.h>
#include <hip/hip_cooperative_groups.h>
#include <cstdio>
#include <cstdint>
namespace cg = cooperative_groups;
namespace pg8 {
#define PG8_LAS __attribute__((address_space(3)))
typedef unsigned short bf16_t;
typedef short bf16x8 __attribute__((ext_vector_type(8)));
typedef float f32x4 __attribute__((ext_vector_type(4)));
typedef unsigned u32x4 __attribute__((ext_vector_type(4)));
constexpr int BM = 256, BK = 64, HALF = 128, HTB = HALF * BK * 2  , STAGE_BYTES = 8 * HTB, NXCD = 8, WGM = 8;

__host__ __device__ __forceinline__ int lds_byte(int r, int c) { const int st = (r >> 4) * 2 + (c >> 5), rr = r & 15, cc = c & 31, ob = rr * 64 + cc * 2; return st * 1024 + (ob ^ (((ob >> 9) & 1) << 5)); }
__host__ __device__ __forceinline__ void stage_rc(int b, int& R, int& C) { const int st = b / 1024, sb = b % 1024, swz = sb ^ (((sb >> 9) & 1) << 5); R = (st >> 1) * 16 + swz / 64; C = (st & 1) * 32 + (swz % 64) / 2; }
__host__ __device__ __forceinline__ int perm32(int rho) { const int n = rho >> 4, i = rho & 15; return 8 * (i >> 2) + 4 * n + (i & 3); }

struct Unit { int pm, pn; };
struct Gemm { const bf16_t* A; const bf16_t* Bt; int M, N, K; };

struct StaticOrder {
    int nM, nN, nwg, G, c;
    __host__ __device__ void init(int M, int N, int G_, int c_) { nM = M / BM; nN = N / BM; nwg = nM * nN; G = G_; c = c_; }
    __host__ __device__ bool next(int i, Unit& u) const {
        const long L = (long)i * G + c; if (L >= nwg) return false;
        int wgid = (int)L; { const int q = nwg / NXCD, r = nwg % NXCD, xcd = wgid % NXCD, off = wgid / NXCD; wgid = (xcd < r ? xcd * (q + 1) : r * (q + 1) + (xcd - r) * q) + off; }
        const int nig = WGM * nN, gid = wgid / nig, fm = gid * WGM, gsz = (nM - fm) < WGM ? (nM - fm) : WGM;
        u.pm = fm + ((wgid % nig) % gsz); u.pn = (wgid % nig) / gsz; return true;
    }
    __device__ __forceinline__ void a_ready(const Unit&) const {}
    __device__ __forceinline__ void done(const Unit&) const {}
};
template <class Epi, class Sched, bool STAMP = false>
__device__ __forceinline__ void gemm_phase(PG8_LAS unsigned char* lds, const Gemm g, const Sched& S, const Epi& E, unsigned long long* stamps, int tid_in) {
    int tid_l = tid_in; asm volatile("" : "+v"(tid_l));
    const int tid = tid_l, wid = __builtin_amdgcn_readfirstlane(tid >> 6), lane = tid & 63, wr = wid >> 2, wc = wid & 3, fr = lane & 15, fq = lane >> 4;
    const int K = g.K, nt = K / BK;
    int ts_lo = 0, ts_hi = 0, nts = 0; const unsigned long long rt_entry = STAMP ? (unsigned long long)wall_clock64() : 0ull;
#define PG8_STAMP() do { if (STAMP && wid == 0 && nts < 64) { const unsigned long long _c = (unsigned long long)clock64(); \
        ts_lo = (lane == nts) ? (int)(unsigned)_c : ts_lo; ts_hi = (lane == nts) ? (int)(unsigned)(_c >> 32) : ts_hi; ++nts; } } while (0)
    PG8_STAMP();
    unsigned voffA[2], voffB[2];
#pragma unroll
    for (int i = 0; i < 2; ++i) { int R, C; stage_rc(tid * 16 + i * 8192, R, C); const int Rb = Epi::PERM ? ((R & ~31) + perm32(R & 31)) : R;
        voffA[i] = (unsigned)(R * K + C) * 2u; voffB[i] = (unsigned)(Rb * K + C) * 2u; }
    const size_t kstep = (size_t)(BK * 2);
    const size_t hstep = (size_t)HALF * K * 2;
    const size_t tstep = 2 * hstep;
    const unsigned ldsw = (unsigned)wid * 1024u;
    const int aoff = lds_byte(wr * 64 + fr, fq * 8), boff = lds_byte(wc * 32 + fr, fq * 8);
#define PG8_SA(b, h) (((b) * 2 + (h)) * HTB)
#define PG8_SB(b, h) ((4 + (b) * 2 + (h)) * HTB)
#define PG8_STAGE(bufoff, gbase, voff) do { _Pragma("unroll") for (int _i = 0; _i < 2; ++_i) \
        __builtin_amdgcn_global_load_lds((const unsigned*)((const char*)(gbase) + (voff)[_i]), (PG8_LAS unsigned*)(lds + (bufoff) + ldsw + _i * 8192), 16, 0, 0); } while (0)
#define PG8_LDA(dst, b, h) do { _Pragma("unroll") for (int m = 0; m < 4; ++m) _Pragma("unroll") for (int k = 0; k < 2; ++k) dst[m][k] = *(const PG8_LAS bf16x8*)(lds + PG8_SA(b, h) + aoff + m * 2048 + k * 1024); } while (0)
#define PG8_LDB(dst, b, h) do { _Pragma("unroll") for (int n = 0; n < 2; ++n) _Pragma("unroll") for (int k = 0; k < 2; ++k) dst[n][k] = *(const PG8_LAS bf16x8*)(lds + PG8_SB(b, h) + boff + n * 2048 + k * 1024); } while (0)
#define PG8_MMA(ai, bj, At, Bt) do { __builtin_amdgcn_s_setprio(1); _Pragma("unroll") for (int m = 0; m < 4; ++m) _Pragma("unroll") for (int n = 0; n < 2; ++n) _Pragma("unroll") for (int k = 0; k < 2; ++k) \
        acc[ai][bj][m][n] = __builtin_amdgcn_mfma_f32_16x16x32_bf16(Bt[n][k], At[m][k], acc[ai][bj][m][n], 0, 0, 0); __builtin_amdgcn_s_setprio(0); } while (0)
#define PG8_WAIT_V(n) asm volatile("s_waitcnt vmcnt(" #n ")" ::: "memory")
#define PG8_WAIT_L(n) asm volatile("s_waitcnt lgkmcnt(" #n ")" ::: "memory")
#define PG8_BAR __builtin_amdgcn_s_barrier()
#define PG8_SCHED __builtin_amdgcn_sched_barrier(0)
    Unit cur, nxt; int ui = 0;
    if (!S.next(0, cur)) return;
    f32x4 acc[2][2][4][2];
#pragma unroll
    for (int a = 0; a < 2; ++a)
#pragma unroll
        for (int b = 0; b < 2; ++b)
#pragma unroll
            for (int m = 0; m < 4; ++m)
#pragma unroll
                for (int n = 0; n < 2; ++n) acc[a][b][m][n] = (f32x4){0.f, 0.f, 0.f, 0.f};
    bf16x8 At[4][2], B0[2][2], B1[2][2];
    const char* cA = (const char*)g.A + (size_t)cur.pm * tstep; const char* cB = (const char*)g.Bt + (size_t)cur.pn * tstep;
    float carry[2][4];
    if constexpr (Epi::CARRY) E.init_carry(cur, carry, wr, fr, fq);
    S.a_ready(cur);
    PG8_STAGE(PG8_SB(0, 0), cB, voffB); PG8_STAGE(PG8_SA(0, 0), cA, voffA); PG8_STAGE(PG8_SB(0, 1), cB + hstep, voffB); PG8_STAGE(PG8_SA(0, 1), cA + hstep, voffA);
    if (wr == 1) PG8_BAR;
    PG8_WAIT_V(4); PG8_BAR;
    PG8_STAGE(PG8_SB(1, 0), cB + kstep, voffB); PG8_STAGE(PG8_SA(1, 0), cA + kstep, voffA); PG8_STAGE(PG8_SB(1, 1), cB + hstep + kstep, voffB);
    PG8_WAIT_V(6); PG8_BAR;
    PG8_STAMP();
    for (;;) {
        const bool has_next = S.next(ui + 1, nxt);
        const char* nA = has_next ? (const char*)g.A + (size_t)nxt.pm * tstep : cA; const char* nB = has_next ? (const char*)g.Bt + (size_t)nxt.pn * tstep : cB;
        for (int t = 0; t < nt; t += 2) {
            const bool last = (t == nt - 2);
            const char* a1 = cA + (size_t)(t + 1) * kstep;
            const char* a2 = last ? nA : cA + (size_t)(t + 2) * kstep; const char* b2 = last ? nB : cB + (size_t)(t + 2) * kstep;
            const char* a3 = a2 + kstep; const char* b3 = b2 + kstep;
            if (last && has_next) S.a_ready(nxt);
            PG8_LDB(B0, 0, 0); PG8_SCHED; PG8_LDA(At, 0, 0); PG8_STAGE(PG8_SA(1, 1), a1 + hstep, voffA);
            PG8_WAIT_L(8); PG8_BAR; PG8_WAIT_L(0); PG8_MMA(0, 0, At, B0); PG8_BAR; PG8_SCHED;
            PG8_LDB(B1, 0, 1); PG8_STAGE(PG8_SB(0, 0), b2, voffB);
            PG8_BAR; PG8_WAIT_L(0); PG8_MMA(0, 1, At, B1); PG8_BAR;
            PG8_LDA(At, 0, 1); PG8_STAGE(PG8_SA(0, 0), a2, voffA);
            PG8_BAR; PG8_WAIT_L(0); PG8_MMA(1, 0, At, B0); PG8_BAR; PG8_SCHED;
            PG8_STAGE(PG8_SB(0, 1), b2 + hstep, voffB);
            PG8_WAIT_V(6); PG8_BAR; PG8_MMA(1, 1, At, B1); PG8_BAR;
            PG8_LDB(B0, 1, 0); PG8_SCHED; PG8_LDA(At, 1, 0); PG8_STAGE(PG8_SA(0, 1), a2 + hstep, voffA);
            PG8_WAIT_L(8); PG8_BAR; PG8_WAIT_L(0); PG8_MMA(0, 0, At, B0); PG8_BAR; PG8_SCHED;
            PG8_LDB(B1, 1, 1); PG8_STAGE(PG8_SB(1, 0), b3, voffB);
            PG8_BAR; PG8_WAIT_L(0); PG8_MMA(0, 1, At, B1); PG8_BAR;
            PG8_LDA(At, 1, 1); PG8_STAGE(PG8_SA(1, 0), a3, voffA);
            PG8_BAR; PG8_WAIT_L(0); PG8_MMA(1, 0, At, B0); PG8_BAR; PG8_SCHED;
            PG8_STAGE(PG8_SB(1, 1), b3 + hstep, voffB);
            PG8_WAIT_V(6); PG8_BAR; PG8_MMA(1, 1, At, B1); PG8_BAR;
        }
        PG8_STAMP();
        if (wr == 0) PG8_BAR;
        if constexpr (Epi::CARRY) { E.run(acc, cur, nxt, has_next, carry, wr, wc, fr, fq); S.done(cur); }
        else if constexpr (!Epi::AFTER_DRAIN) { E(acc, cur, wr, wc, fr, fq); S.done(cur); }
        PG8_STAMP();
        if (!has_next) break;
#pragma unroll
        for (int a = 0; a < 2; ++a)
#pragma unroll
            for (int b = 0; b < 2; ++b)
#pragma unroll
                for (int m = 0; m < 4; ++m)
#pragma unroll
                    for (int n = 0; n < 2; ++n) acc[a][b][m][n] = (f32x4){0.f, 0.f, 0.f, 0.f};
        cur = nxt; cA = nA; cB = nB; ++ui;
        if (wr == 1) PG8_BAR;
    }
    PG8_WAIT_V(0);
    PG8_BAR;
    if constexpr (Epi::AFTER_DRAIN) { E.fused(acc, cur, wr, wc, fr, fq, lds, wid, lane); S.done(cur); }
    PG8_STAMP();
    if (STAMP && wid == 0) { stamps[lane] = lane < nts ? (((unsigned long long)(unsigned)ts_hi << 32) | (unsigned)ts_lo) : 0ull;
        if (lane == 62) stamps[62] = rt_entry; if (lane == 63) stamps[63] = (unsigned long long)wall_clock64(); }
#undef PG8_STAMP
#undef PG8_SA
#undef PG8_SB
#undef PG8_STAGE
#undef PG8_LDA
#undef PG8_LDB
#undef PG8_MMA
#undef PG8_WAIT_V
#undef PG8_WAIT_L
#undef PG8_BAR
#undef PG8_SCHED
}
}

using pg8::bf16_t;
using pg8::f32x4;
using pg8::u32x4;
using pg8::Unit;
typedef short bf16x8 __attribute__((ext_vector_type(8)));
typedef float f32x16 __attribute__((ext_vector_type(16)));
typedef unsigned u32x2 __attribute__((ext_vector_type(2)));
typedef short s16x4 __attribute__((ext_vector_type(4)));

#ifndef ENMASK
#define ENMASK 0xffff
#endif
#define EN(k) ((ENMASK >> (k)) & 1)
#ifndef REPMASK
#define REPMASK 0
#endif
#define NREP(k) (1 + ((REPMASK >> (k)) & 1))
#ifndef EXTRA_N
#define EXTRA_N 0
#endif
#ifndef EXTRA_Q
#define EXTRA_Q 5
#endif
constexpr int T_ = 32768, S_ = 2048;
constexpr float EPSV = 1e-6f;
constexpr float LOG2E = 1.4426950408889634f;
constexpr size_t MiB = (size_t)1 << 20;
constexpr size_t WS_COSA = 0, WS_SINA = 128 * 1024, WS_COSB = 256 * 1024, WS_SINB = 512 * 1024;
constexpr size_t WS_SSQ = 1 * MiB;
constexpr size_t WS_W = 2 * MiB;
constexpr size_t W_IN = WS_W, W_UP = WS_W + 8 * MiB, W_EOUT = WS_W + 11 * MiB, W_QKV = WS_W + 15 * MiB, W_OOUT = WS_W + 27 * MiB, W_GU = WS_W + 31 * MiB, W_DN = WS_W + 75 * MiB;
constexpr size_t SZ_IN = 4 * MiB, SZ_UP = 3 * MiB / 2, SZ_EOUT = 2 * MiB, SZ_QKV = 6 * MiB, SZ_OOUT = 2 * MiB, SZ_GU = 11 * MiB, SZ_DN = 11 * MiB / 2;
constexpr size_t WS_XN = 100 * MiB, WS_O = 164 * MiB, WS_R = 228 * MiB;
constexpr size_t R_QB = WS_R, R_KB = WS_R + 32 * MiB, R_VBT = WS_R + 64 * MiB, R_A2 = WS_R + 96 * MiB, R_KPE = WS_R + 120 * MiB, R_QA = WS_R + 122 * MiB, R_KA = WS_R + 170 * MiB, R_VAT = WS_R + 202 * MiB;
constexpr size_t R_QC = WS_R, R_KC = WS_R + 64 * MiB, R_VCT = WS_R + 128 * MiB;
constexpr size_t R_HFF = WS_R;
constexpr size_t R_VB = WS_R + 234 * MiB;
constexpr size_t WS_NSSQ = WS_R + 266 * MiB;
constexpr size_t WS_END = WS_NSSQ + 2 * MiB;
constexpr size_t WS_BAR = 896 * 1024;

struct Params {
    const float* in[17];
    float* out;
    unsigned char* ws;
};

__device__ __forceinline__ unsigned cvt_pk_bf16(float lo, float hi) { unsigned r; asm("v_cvt_pk_bf16_f32 %0, %1, %2" : "=v"(r) : "v"(lo), "v"(hi)); return r; }
__device__ __forceinline__ bf16_t f2bf(float f) { return (bf16_t)(cvt_pk_bf16(f, 0.f) & 0xffffu); }
__device__ __forceinline__ float xshfl(float v, int lane, int mask) { return __builtin_bit_cast(float, __builtin_amdgcn_ds_bpermute((lane ^ mask) << 2, __builtin_bit_cast(int, v))); }
__device__ __forceinline__ float fexp2(float x) { return __builtin_amdgcn_exp2f(x); }
__device__ __forceinline__ u32x2 pk4(f32x4 v) { u32x2 o; o.x = cvt_pk_bf16(v[0], v[1]); o.y = cvt_pk_bf16(v[2], v[3]); return o; }
__device__ __forceinline__ u32x4 pk8(f32x4 a, f32x4 b) { u32x4 o; o.x = cvt_pk_bf16(a[0], a[1]); o.y = cvt_pk_bf16(a[2], a[3]); o.z = cvt_pk_bf16(b[0], b[1]); o.w = cvt_pk_bf16(b[2], b[3]); return o; }


#define XB_TMO      128
#define XB_XCNT(j)  (256  + 64 * (j))
#define XB_XSUB(j)  (1280 + 64 * (j))
#define XB_XGEN(j)  (2304 + 64 * (j))
#define XB_TOP      3328
#define XB_TOPGEN   3392
#define XCD_BAR_WORDS 3456
#define XB_SPIN_CAP (1u << 20)
__device__ __forceinline__ unsigned xb_ld(unsigned* p)              { return __hip_atomic_load(p, __ATOMIC_RELAXED, __HIP_MEMORY_SCOPE_AGENT); }
__device__ __forceinline__ unsigned xb_add(unsigned* p, unsigned v) { return __hip_atomic_fetch_add(p, v, __ATOMIC_RELAXED, __HIP_MEMORY_SCOPE_AGENT); }
__device__ __forceinline__ unsigned xb_xcc_id() { return (unsigned)__builtin_amdgcn_s_getreg((3 << 11) | 20) & 0xFu; }
#define XB_SPIN(cond, bar) do { unsigned _sp = 0; while (cond) { __builtin_amdgcn_s_sleep(1); \
    if ((++_sp & 255u) == 0u) { if (xb_ld(&(bar)[XB_TMO])) break; if (_sp > XB_SPIN_CAP) { atomicAdd(&(bar)[XB_TMO], 1u); break; } } } } while (0)
__device__ __forceinline__ void xcd_barrier_complete(unsigned* bar, unsigned x, unsigned& nloc, unsigned& nx) {
    const unsigned G = gridDim.x;
    unsigned sum, cnt, mine, sp = 0u;
    for (;;) {
        sum = 0u; cnt = 0u; mine = 0u;
#pragma unroll
        for (unsigned j = 0; j < 16; ++j) { const unsigned c = xb_ld(&bar[XB_XCNT(j)]); sum += c; cnt += (c > 0u) ? 1u : 0u; mine = (j == x) ? c : mine; }
        if (sum == G) break;
        __builtin_amdgcn_s_sleep(1);
        if ((++sp & 255u) == 0u) { if (xb_ld(&bar[XB_TMO])) break; if (sp > XB_SPIN_CAP) { atomicAdd(&bar[XB_TMO], 1u); break; } }
    }
    nloc = mine > 0u ? mine : 1u; nx = cnt > 0u ? cnt : 1u;
}
__device__ __forceinline__ void xcd_barrier(unsigned* bar, unsigned x, volatile PG8_LAS unsigned* st, int tid) {
    asm volatile("s_waitcnt vmcnt(0)" ::: "memory");
    __syncthreads();
    if (tid == 0) {
        __builtin_amdgcn_s_waitcnt(0);
        unsigned nloc = st[0], nx = st[1];
        if (nloc == 0u) { xcd_barrier_complete(bar, x, nloc, nx); st[0] = nloc; st[1] = nx; }
        const unsigned old = xb_add(&bar[XB_XSUB(x)], 1u);
        const unsigned gen = old / nloc;
        if (old + 1u == (gen + 1u) * nloc) {
            __builtin_amdgcn_fence(__ATOMIC_RELEASE, "agent");
            asm volatile("s_waitcnt vmcnt(0)" ::: "memory");
            const unsigned og = xb_add(&bar[XB_TOP], 1u);
            const unsigned tg = og / nx;
            if (og + 1u == (tg + 1u) * nx) xb_add(&bar[XB_TOPGEN], 1u);
            else XB_SPIN(xb_ld(&bar[XB_TOPGEN]) == tg, bar);
            __builtin_amdgcn_fence(__ATOMIC_ACQUIRE, "agent");
            xb_add(&bar[XB_XGEN(x)], 1u);
            asm volatile("s_waitcnt vmcnt(0)" ::: "memory");
        } else {
            XB_SPIN(xb_ld(&bar[XB_XGEN(x)]) == gen, bar);
            __builtin_amdgcn_fence(__ATOMIC_ACQUIRE, "agent");
            asm volatile("s_waitcnt vmcnt(0)" ::: "memory");
        }
    }
    __syncthreads();
}

__device__ __forceinline__ void row_rs8(const float* __restrict__ nssq, int row0, int fr, int fq, float (&rs)[2][4]) {
    f32x4 part[2][4];
#pragma unroll
    for (int ai = 0; ai < 2; ++ai)
#pragma unroll
        for (int m = 0; m < 4; ++m) part[ai][m] = *(const f32x4*)(nssq + (size_t)(row0 + ai * 128 + m * 16) * 16 + 4 * fq);
#pragma unroll
    for (int ai = 0; ai < 2; ++ai)
#pragma unroll
        for (int m = 0; m < 4; ++m) { float s = part[ai][m][0] + part[ai][m][1] + part[ai][m][2] + part[ai][m][3];
            s += xshfl(s, fr + 16 * fq, 16); s += xshfl(s, fr + 16 * fq, 32);
            rs[ai][m] = rsqrtf(s * (1.f / 1024.f) + EPSV); }
}
__device__ __forceinline__ void carry_issue(const float* __restrict__ nssq, int nrow0, int fq, f32x4 (&part)[2][4]) {
#pragma unroll
    for (int ai = 0; ai < 2; ++ai)
#pragma unroll
        for (int m = 0; m < 4; ++m) part[ai][m] = *(const f32x4*)(nssq + (size_t)(nrow0 + ai * 128 + m * 16) * 16 + 4 * fq);
}
__device__ __forceinline__ void carry_reduce(const f32x4 (&part)[2][4], float (&carry)[2][4], int fr, int fq) {
#pragma unroll
    for (int ai = 0; ai < 2; ++ai)
#pragma unroll
        for (int m = 0; m < 4; ++m) { float sq = part[ai][m][0] + part[ai][m][1] + part[ai][m][2] + part[ai][m][3];
            sq += xshfl(sq, fr + 16 * fq, 16); sq += xshfl(sq, fr + 16 * fq, 32);
            carry[ai][m] = rsqrtf(sq * (1.f / 1024.f) + EPSV); }
}
struct EpiResid {
    static constexpr bool PERM = false, AFTER_DRAIN = false, CARRY = false;
    const float* x0; bf16_t* xn; float* nssq;
    __device__ __forceinline__ void operator()(const f32x4 (&acc)[2][2][4][2], const Unit& u, int wr, int wc, int fr, int fq) const {
        asm volatile("" : "+v"(fr), "+v"(fq));
        const int row0 = u.pm * 256 + wr * 64 + fr, col0 = u.pn * 256 + wc * 32 + 8 * fq;
        float ssv[2][4];
#pragma unroll
        for (int ai = 0; ai < 2; ++ai) {
            f32x4 hv[4][2][2];
            if (x0) {
#pragma unroll
                for (int m = 0; m < 4; ++m)
#pragma unroll
                    for (int bj = 0; bj < 2; ++bj)
#pragma unroll
                        for (int n = 0; n < 2; ++n) hv[m][bj][n] = *(const f32x4*)(x0 + (size_t)(row0 + ai * 128 + m * 16) * 1024 + col0 + bj * 128 + n * 4);
            } else {
                u32x4 hb[4][2];
#pragma unroll
                for (int m = 0; m < 4; ++m)
#pragma unroll
                    for (int bj = 0; bj < 2; ++bj) hb[m][bj] = *(const u32x4*)(xn + (size_t)(row0 + ai * 128 + m * 16) * 1024 + col0 + bj * 128);
#pragma unroll
                for (int m = 0; m < 4; ++m)
#pragma unroll
                    for (int bj = 0; bj < 2; ++bj) { const u32x4 t = hb[m][bj]; f32x4 v0, v1;
                        v0[0] = __uint_as_float(t.x << 16); v0[1] = __uint_as_float(t.x & 0xffff0000u); v0[2] = __uint_as_float(t.y << 16); v0[3] = __uint_as_float(t.y & 0xffff0000u);
                        v1[0] = __uint_as_float(t.z << 16); v1[1] = __uint_as_float(t.z & 0xffff0000u); v1[2] = __uint_as_float(t.w << 16); v1[3] = __uint_as_float(t.w & 0xffff0000u);
                        hv[m][bj][0] = v0; hv[m][bj][1] = v1; }
            }
#pragma unroll
            for (int m = 0; m < 4; ++m) { const int row = row0 + ai * 128 + m * 16; float ss = 0.f;
#pragma unroll
                for (int bj = 0; bj < 2; ++bj) { const u32x4 pk = pk8(hv[m][bj][0] + acc[ai][bj][m][0], hv[m][bj][1] + acc[ai][bj][m][1]);
                    *(u32x4*)(xn + (size_t)row * 1024 + col0 + bj * 128) = pk;
                    const float r0 = __uint_as_float(pk.x << 16), r1 = __uint_as_float(pk.x & 0xffff0000u), r2 = __uint_as_float(pk.y << 16), r3 = __uint_as_float(pk.y & 0xffff0000u);
                    const float r4 = __uint_as_float(pk.z << 16), r5 = __uint_as_float(pk.z & 0xffff0000u), r6 = __uint_as_float(pk.w << 16), r7 = __uint_as_float(pk.w & 0xffff0000u);
                    ss += r0 * r0 + r1 * r1 + r2 * r2 + r3 * r3 + r4 * r4 + r5 * r5 + r6 * r6 + r7 * r7; }
                ss += xshfl(ss, fr + 16 * fq, 16); ss += xshfl(ss, fr + 16 * fq, 32);
                ssv[ai][m] = ss; }
            __builtin_amdgcn_sched_barrier(0);
        }
#pragma unroll
        for (int ai = 0; ai < 2; ++ai) { const float v = fq == 0 ? ssv[ai][0] : fq == 1 ? ssv[ai][1] : fq == 2 ? ssv[ai][2] : ssv[ai][3];
            nssq[(size_t)(row0 + ai * 128 + fq * 16) * 16 + 4 * u.pn + wc] = v; }
    }
};
struct EpiGateUp {
    static constexpr bool PERM = false, AFTER_DRAIN = false, CARRY = true;
    bf16_t* hff; const float* nssq;
    __device__ __forceinline__ void init_carry(const Unit& u, float (&carry)[2][4], int wr, int fr, int fq) const { row_rs8(nssq, u.pm * 256 + wr * 64 + fr, fr, fq, carry); }
    __device__ __forceinline__ void run(const f32x4 (&acc)[2][2][4][2], const Unit& u, const Unit& nx, bool has_next, float (&carry)[2][4], int wr, int wc, int fr, int fq) const {
        asm volatile("" : "+v"(fr), "+v"(fq));
        const int row0 = u.pm * 256 + wr * 64 + fr, fcol = u.pn * 128 + wc * 32 + 8 * fq;
        const int nrow0 = (has_next ? nx.pm : u.pm) * 256 + wr * 64 + fr;
        f32x4 part[2][4];
#pragma unroll
        for (int ai = 0; ai < 2; ++ai)
#pragma unroll
            for (int m = 0; m < 4; ++m) part[ai][m] = *(const f32x4*)(nssq + (size_t)(nrow0 + ai * 128 + m * 16) * 16 + 4 * fq);
#pragma unroll
        for (int ai = 0; ai < 2; ++ai)
#pragma unroll
            for (int m = 0; m < 4; ++m) {
                const float rs = carry[ai][m];
                f32x4 r0, r1;
#pragma unroll
                for (int j = 0; j < 4; ++j) {
                    const float g0 = acc[ai][0][m][0][j] * rs, g1 = acc[ai][0][m][1][j] * rs;
                    r0[j] = g0 * __builtin_amdgcn_rcpf(1.f + fexp2(-g0 * LOG2E)) * (acc[ai][1][m][0][j] * rs);
                    r1[j] = g1 * __builtin_amdgcn_rcpf(1.f + fexp2(-g1 * LOG2E)) * (acc[ai][1][m][1][j] * rs);
                }
                *(u32x4*)(hff + (size_t)(row0 + ai * 128 + m * 16) * 2816 + fcol) = pk8(r0, r1);
            }
#pragma unroll
        for (int ai = 0; ai < 2; ++ai)
#pragma unroll
            for (int m = 0; m < 4; ++m) { float sq = part[ai][m][0] + part[ai][m][1] + part[ai][m][2] + part[ai][m][3];
                sq += xshfl(sq, fr + 16 * fq, 16); sq += xshfl(sq, fr + 16 * fq, 32);
                carry[ai][m] = rsqrtf(sq * (1.f / 1024.f) + EPSV); }
    }
};
struct EpiEvenIn {
    static constexpr bool PERM = false, AFTER_DRAIN = false, CARRY = false;
    unsigned char* ws; const float* nssq;
    __device__ __forceinline__ void operator()(const f32x4 (&acc)[2][2][4][2], const Unit& u, int wr, int wc, int fr, int fq) const {
        asm volatile("" : "+v"(fr), "+v"(fq));
        bf16_t* const qb = (bf16_t*)(ws + R_QB); bf16_t* const kb = (bf16_t*)(ws + R_KB); bf16_t* const vbt = (bf16_t*)(ws + R_VBT); bf16_t* const a2 = (bf16_t*)(ws + R_A2); bf16_t* const kpe = (bf16_t*)(ws + R_KPE);
        float* const ssq = (float*)(ws + WS_SSQ); const float* const cosA = (const float*)(ws + WS_COSA); const float* const sinA = (const float*)(ws + WS_SINA); const float* const cosB = (const float*)(ws + WS_COSB); const float* const sinB = (const float*)(ws + WS_SINB);
        const int row0 = u.pm * 256 + wr * 64 + fr, pn = u.pn;
        float rs8[2][4]; row_rs8(nssq, row0, fr, fq, rs8);
        if (pn < 4) {
            bf16_t* dst = pn < 2 ? qb : kb; const float sc = pn < 2 ? 0.125f * LOG2E : 1.f;
            const int hcol = (4 * (pn & 1) + wc) * 64 + 8 * fq;
#pragma unroll
            for (int ai = 0; ai < 2; ++ai) {
                f32x4 cc[4][2], sn[4][2];
#pragma unroll
                for (int m = 0; m < 4; ++m)
#pragma unroll
                    for (int n = 0; n < 2; ++n) { const int pos = (row0 + ai * 128 + m * 16) & 2047; cc[m][n] = *(const f32x4*)(cosB + pos * 32 + 8 * fq + 4 * n); sn[m][n] = *(const f32x4*)(sinB + pos * 32 + 8 * fq + 4 * n); }
#pragma unroll
                for (int m = 0; m < 4; ++m) { const int row = row0 + ai * 128 + m * 16; const float rsc = rs8[ai][m] * sc;
                    f32x4 o1[2], o2[2];
#pragma unroll
                    for (int n = 0; n < 2; ++n) { const f32x4 x1 = acc[ai][0][m][n], x2 = acc[ai][1][m][n];
                        o1[n] = (x1 * cc[m][n] - x2 * sn[m][n]) * rsc; o2[n] = (x2 * cc[m][n] + x1 * sn[m][n]) * rsc; }
                    bf16_t* p = dst + (size_t)row * 512 + hcol;
                    *(u32x4*)p = pk8(o1[0], o1[1]); *(u32x4*)(p + 32) = pk8(o2[0], o2[1]); }
                __builtin_amdgcn_sched_barrier(0);
            }
        } else if (pn < 6) {
            bf16_t* const vb = (bf16_t*)(ws + R_VB);
#pragma unroll
            for (int ai = 0; ai < 2; ++ai)
#pragma unroll
                for (int m = 0; m < 4; ++m) { const int row = row0 + ai * 128 + m * 16, pos = row & 2047, b = row >> 11; const float rs = rs8[ai][m];
#pragma unroll
                    for (int bj = 0; bj < 2; ++bj) { const int f0 = (pn - 4) * 256 + bj * 128 + wc * 32 + 8 * fq;
                        const f32x4 y0 = acc[ai][bj][m][0] * rs, y1 = acc[ai][bj][m][1] * rs;
                        *(u32x4*)(vb + (size_t)row * 512 + f0) = pk8(y0, y1);
                    }
                    __builtin_amdgcn_sched_barrier(0); }
        } else if (pn == 6) {
            float ssv[2][4];
#pragma unroll
            for (int ai = 0; ai < 2; ++ai)
#pragma unroll
                for (int m = 0; m < 4; ++m) { const int row = row0 + ai * 128 + m * 16; float ss = 0.f; const float rs = rs8[ai][m];
#pragma unroll
                    for (int bj = 0; bj < 2; ++bj) { const f32x4 v0 = acc[ai][bj][m][0] * rs, v1 = acc[ai][bj][m][1] * rs;
#pragma unroll
                        for (int j = 0; j < 4; ++j) ss += v0[j] * v0[j] + v1[j] * v1[j];
                        *(u32x4*)(a2 + (size_t)row * 384 + bj * 128 + wc * 32 + 8 * fq) = pk8(v0, v1); }
                    ss += xshfl(ss, fr + 16 * fq, 16); ss += xshfl(ss, fr + 16 * fq, 32);
                    ssv[ai][m] = ss; }
#pragma unroll
            for (int ai = 0; ai < 2; ++ai) ssq[(size_t)(row0 + ai * 128 + fq * 16) * 8 + wc] = fq == 0 ? ssv[ai][0] : fq == 1 ? ssv[ai][1] : fq == 2 ? ssv[ai][2] : ssv[ai][3];
        } else {
            float ssv[2][4];
#pragma unroll
            for (int ai = 0; ai < 2; ++ai) {
                f32x4 cc[4], sn[4];
                if (wc == 0) {
#pragma unroll
                    for (int m = 0; m < 4; ++m) { const int pos = (row0 + ai * 128 + m * 16) & 2047; cc[m] = *(const f32x4*)(cosA + pos * 16 + 4 * fq); sn[m] = *(const f32x4*)(sinA + pos * 16 + 4 * fq); }
                }
#pragma unroll
                for (int m = 0; m < 4; ++m) { const int row = row0 + ai * 128 + m * 16; float ss = 0.f; const float rs = rs8[ai][m];
                    { const f32x4 v0 = acc[ai][0][m][0] * rs, v1 = acc[ai][0][m][1] * rs;
#pragma unroll
                      for (int j = 0; j < 4; ++j) ss += v0[j] * v0[j] + v1[j] * v1[j];
                      *(u32x4*)(a2 + (size_t)row * 384 + 256 + wc * 32 + 8 * fq) = pk8(v0, v1); }
                    ss += xshfl(ss, fr + 16 * fq, 16); ss += xshfl(ss, fr + 16 * fq, 32);
                    ssv[ai][m] = ss;
                    if (wc == 0) { const f32x4 x1 = acc[ai][1][m][0] * rs, x2 = acc[ai][1][m][1] * rs;
                        bf16_t* p = kpe + (size_t)row * 32 + 4 * fq;
                        *(u32x2*)p = pk4(x1 * cc[m] - x2 * sn[m]); *(u32x2*)(p + 16) = pk4(x2 * cc[m] + x1 * sn[m]); } }
                __builtin_amdgcn_sched_barrier(0);
            }
#pragma unroll
            for (int ai = 0; ai < 2; ++ai) ssq[(size_t)(row0 + ai * 128 + fq * 16) * 8 + 4 + wc] = fq == 0 ? ssv[ai][0] : fq == 1 ? ssv[ai][1] : fq == 2 ? ssv[ai][2] : ssv[ai][3];
        }
    }
};
struct EpiEvenUp {
    static constexpr bool PERM = false, AFTER_DRAIN = false, CARRY = false;
    unsigned char* ws;
    __device__ __forceinline__ void operator()(const f32x4 (&acc)[2][2][4][2], const Unit& u, int wr, int wc, int fr, int fq) const {
        asm volatile("" : "+v"(fr), "+v"(fq));
        bf16_t* const qa = (bf16_t*)(ws + R_QA); bf16_t* const ka = (bf16_t*)(ws + R_KA); bf16_t* const vat = (bf16_t*)(ws + R_VAT);
        const float* const ssq = (const float*)(ws + WS_SSQ); const float* const cosA = (const float*)(ws + WS_COSA); const float* const sinA = (const float*)(ws + WS_SINA);
        const int row0 = u.pm * 256 + wr * 64 + fr, pn = u.pn;
        float rs8[2][4];
        { f32x4 q[2][4];
#pragma unroll
          for (int ai = 0; ai < 2; ++ai)
#pragma unroll
              for (int m = 0; m < 4; ++m) q[ai][m] = *(const f32x4*)(ssq + (size_t)(row0 + ai * 128 + m * 16) * 8 + (pn < 3 ? 0 : 4));
          const float dinv = pn < 3 ? (1.f / 256.f) : (1.f / 128.f), mul = pn < 3 ? (0.10206207261596575f * LOG2E) : 1.f;
#pragma unroll
          for (int ai = 0; ai < 2; ++ai)
#pragma unroll
              for (int m = 0; m < 4; ++m) rs8[ai][m] = rsqrtf((q[ai][m][0] + q[ai][m][1] + q[ai][m][2] + q[ai][m][3]) * dinv + EPSV) * mul; }
        if (pn < 3) {
            int hoff[2], part[2];
#pragma unroll
            for (int bj = 0; bj < 2; ++bj) { const int G = 8 * pn + 4 * bj + wc, head = G / 3; part[bj] = G - 3 * head; hoff[bj] = head * 96 + (part[bj] < 2 ? 32 * part[bj] + 8 * fq : 64 + 4 * fq); }
            const bool anyrope = (part[0] == 2) || (part[1] == 2);
#pragma unroll
            for (int ai = 0; ai < 2; ++ai) {
                f32x4 cc[4], sn[4];
                if (anyrope) {
#pragma unroll
                    for (int m = 0; m < 4; ++m) { const int pos = (row0 + ai * 128 + m * 16) & 2047; cc[m] = *(const f32x4*)(cosA + pos * 16 + 4 * fq); sn[m] = *(const f32x4*)(sinA + pos * 16 + 4 * fq); }
                }
#pragma unroll
                for (int m = 0; m < 4; ++m) { const int row = row0 + ai * 128 + m * 16; const float rs = rs8[ai][m];
#pragma unroll
                    for (int bj = 0; bj < 2; ++bj) {
                        const f32x4 x1 = acc[ai][bj][m][0] * rs, x2 = acc[ai][bj][m][1] * rs;
                        bf16_t* p = qa + (size_t)row * 768 + hoff[bj];
                        if (part[bj] < 2) *(u32x4*)p = pk8(x1, x2);
                        else { *(u32x2*)p = pk4(x1 * cc[m] - x2 * sn[m]); *(u32x2*)(p + 16) = pk4(x2 * cc[m] + x1 * sn[m]); } } }
                __builtin_amdgcn_sched_barrier(0);
            }
        } else {
            int head[2], part[2];
#pragma unroll
            for (int bj = 0; bj < 2; ++bj) { const int G = 8 * (pn - 3) + 4 * bj + wc; head[bj] = G >> 2; part[bj] = G & 3; }
#pragma unroll
            for (int ai = 0; ai < 2; ++ai)
#pragma unroll
                for (int m = 0; m < 4; ++m) { const int row = row0 + ai * 128 + m * 16, pos = row & 2047, b = row >> 11; const float rs = rs8[ai][m];
#pragma unroll
                    for (int bj = 0; bj < 2; ++bj) {
                        const f32x4 x1 = acc[ai][bj][m][0] * rs, x2 = acc[ai][bj][m][1] * rs;
                        if (part[bj] < 2) *(u32x4*)(ka + (size_t)row * 512 + head[bj] * 64 + 32 * part[bj] + 8 * fq) = pk8(x1, x2);
                        else *(u32x4*)(vat + (size_t)row * 512 + head[bj] * 64 + 32 * (part[bj] - 2) + 8 * fq) = pk8(x1, x2); }
                    __builtin_amdgcn_sched_barrier(0); }
        }
    }
};
struct EpiOddQKV {
    static constexpr bool PERM = false, AFTER_DRAIN = false, CARRY = true;
    unsigned char* ws; const float* nssq;
    __device__ __forceinline__ void init_carry(const Unit& u, float (&carry)[2][4], int wr, int fr, int fq) const { row_rs8(nssq, u.pm * 256 + wr * 64 + fr, fr, fq, carry); }
    __device__ __forceinline__ void run(const f32x4 (&acc)[2][2][4][2], const Unit& u, const Unit& nx, bool has_next, float (&carry)[2][4], int wr, int wc, int fr, int fq) const {
        asm volatile("" : "+v"(fr), "+v"(fq));
        bf16_t* const qc = (bf16_t*)(ws + R_QC); bf16_t* const kc = (bf16_t*)(ws + R_KC); bf16_t* const vct = (bf16_t*)(ws + R_VCT);
        const int row0 = u.pm * 256 + wr * 64 + fr, pn = u.pn;
        f32x4 part[2][4]; carry_issue(nssq, (has_next ? nx.pm : u.pm) * 256 + wr * 64 + fr, fq, part);
        float rs8[2][4];
#pragma unroll
        for (int ai = 0; ai < 2; ++ai)
#pragma unroll
            for (int m = 0; m < 4; ++m) rs8[ai][m] = carry[ai][m];
        if (pn < 8) {
            bf16_t* dst = pn < 4 ? qc : kc; const float sc = pn < 4 ? 0.125f * LOG2E : 1.f;
#pragma unroll
            for (int ai = 0; ai < 2; ++ai)
#pragma unroll
                for (int m = 0; m < 4; ++m) { const int row = row0 + ai * 128 + m * 16; const float rsc = rs8[ai][m] * sc;
#pragma unroll
                    for (int bj = 0; bj < 2; ++bj)
                        *(u32x4*)(dst + (size_t)row * 1024 + (pn & 3) * 256 + bj * 128 + wc * 32 + 8 * fq) = pk8(acc[ai][bj][m][0] * rsc, acc[ai][bj][m][1] * rsc); }
        } else {
#pragma unroll
            for (int ai = 0; ai < 2; ++ai)
#pragma unroll
                for (int m = 0; m < 4; ++m) { const int row = row0 + ai * 128 + m * 16; const float rs = rs8[ai][m];
#pragma unroll
                    for (int bj = 0; bj < 2; ++bj)
                        *(u32x4*)(vct + (size_t)row * 1024 + (pn - 8) * 256 + bj * 128 + wc * 32 + 8 * fq) = pk8(acc[ai][bj][m][0] * rs, acc[ai][bj][m][1] * rs); }
        }
        carry_reduce(part, carry, fr, fq);
    }
};

enum { MAP_IDENT = 0, MAP_EVIN, MAP_QUP, MAP_KVUP, MAP_ODQKV, MAP_GU, MAP_P32 };
__device__ __forceinline__ int p32(int w) { return (w & ~31) + pg8::perm32(w & 31); }
__device__ __forceinline__ int src_col(int map, int c, int sel) {
    switch (map) {
    case MAP_EVIN: { const int pn = c >> 8, w = c & 255;
        if (pn < 4) { const int bj = w >> 7, wc = (w >> 5) & 3, d = pg8::perm32(w & 31) + 32 * bj, head = 4 * (pn & 1) + wc; return 416 + (pn >> 1) * 512 + head * 64 + d; }
        if (pn < 6) return 416 + 1024 + (pn - 4) * 256 + p32(w);
        if (pn == 6) return p32(w);
        if (w < 128) return 256 + p32(w);
        if (w < 160) return 384 + (w - 128);
        return -1; }
    case MAP_QUP: { const int G = c >> 5, head = G / 3, part = G - 3 * head, rho = c & 31; return part < 2 ? head * 96 + 32 * part + pg8::perm32(rho) : head * 96 + 64 + rho; }
    case MAP_KVUP: { const int G = c >> 5, head = G >> 2, part = G & 3, rho = c & 31; return head * 128 + 32 * part + pg8::perm32(rho); }
    case MAP_ODQKV: { const int which = c >> 10, f = c & 1023; return which * 1024 + p32(f); }
    case MAP_GU: { const int pn = c >> 8, bj = (c >> 7) & 1, w = c & 127; if (bj != sel) return -2; return 128 * pn + p32(w); }
    case MAP_P32: return p32(c);
    default: return c;
    }
}
__device__ __forceinline__ void prep_w(float* tl, const float* __restrict__ W, int Nsrc, int Ksrc, const float* __restrict__ gain, bf16_t* Bt, int Kt, int klo, int row0, int nrows, int map, int sel) {
    const int tid = threadIdx.x, nkt = Kt >> 7, ntile = (nrows >> 6) * nkt;
    for (int t = blockIdx.x; t < ntile; t += gridDim.x) {
        const int tr = t / nkt, tk = t - tr * nkt;
        if (map == MAP_GU && src_col(map, tr * 64, sel) == -2) continue;
        { const int c = tid & 63, kq = tid >> 6, src = src_col(map, tr * 64 + c, sel);
          float v[16];
#pragma unroll
          for (int i = 0; i < 16; ++i) { const int ks = tk * 128 + kq * 16 + i - klo; v[i] = 0.f;
              if (src >= 0 && ks >= 0 && ks < Ksrc) v[i] = W[(size_t)ks * Nsrc + src]; }
          if (gain) {
#pragma unroll
              for (int i = 0; i < 16; ++i) { const int ks = tk * 128 + kq * 16 + i - klo; if (src >= 0 && ks >= 0 && ks < Ksrc) v[i] *= gain[ks]; } }
#pragma unroll
          for (int i = 0; i < 16; ++i) tl[(kq * 16 + i) * 65 + c] = v[i]; }
        __syncthreads();
#pragma unroll
        for (int half = 0; half < 2; ++half) { const int kc = tid & 15, c = (tid >> 4) + 32 * half; float v[8];
#pragma unroll
          for (int i = 0; i < 8; ++i) v[i] = tl[(kc * 8 + i) * 65 + c];
          u32x4 o; o.x = cvt_pk_bf16(v[0], v[1]); o.y = cvt_pk_bf16(v[2], v[3]); o.z = cvt_pk_bf16(v[4], v[5]); o.w = cvt_pk_bf16(v[6], v[7]);
          *(u32x4*)(Bt + (size_t)(row0 + tr * 64 + c) * Kt + tk * 128 + kc * 8) = o; }
        __syncthreads();
    }
}

__device__ __forceinline__ void norm_phase(const float* __restrict__ h, bf16_t* xn, float* outf, const float* __restrict__ g, float* ssq_out, int gw, int nw, int lane) {
    for (int row = gw; row < T_; row += nw) {
        const f32x4* p = (const f32x4*)(h + (size_t)row * 1024);
        f32x4 v[4]; float ss = 0.f;
#pragma unroll
        for (int i = 0; i < 4; ++i) { v[i] = p[lane + 64 * i]; ss += v[i][0] * v[i][0] + v[i][1] * v[i][1] + v[i][2] * v[i][2] + v[i][3] * v[i][3]; }
#pragma unroll
        for (int o = 32; o >= 1; o >>= 1) ss += xshfl(ss, lane, o);
        const float rs = rsqrtf(ss * (1.f / 1024.f) + EPSV);
        if (outf) {
#pragma unroll
            for (int i = 0; i < 4; ++i) { const f32x4 gg = *(const f32x4*)(g + 4 * (lane + 64 * i)); *(f32x4*)(outf + (size_t)row * 1024 + 4 * (lane + 64 * i)) = v[i] * rs * gg; }
        } else {
#pragma unroll
            for (int i = 0; i < 4; ++i) *(u32x2*)(xn + (size_t)row * 1024 + 4 * (lane + 64 * i)) = pk4(v[i]);
            if (lane < 16) ssq_out[row * 16 + lane] = lane == 0 ? ss : 0.f;
        }
    }
}

__device__ __forceinline__ void final_norm_phase(const bf16_t* __restrict__ xn, float* outf, const float* __restrict__ g, int gw, int nw, int lane) {
    for (int row = gw; row < T_; row += nw) {
        const u32x4* p = (const u32x4*)(xn + (size_t)row * 1024);
        f32x4 v[4]; float ss = 0.f;
#pragma unroll
        for (int i = 0; i < 2; ++i) { const u32x4 t = p[lane + 64 * i];
            v[2 * i][0] = __uint_as_float(t.x << 16); v[2 * i][1] = __uint_as_float(t.x & 0xffff0000u); v[2 * i][2] = __uint_as_float(t.y << 16); v[2 * i][3] = __uint_as_float(t.y & 0xffff0000u);
            v[2 * i + 1][0] = __uint_as_float(t.z << 16); v[2 * i + 1][1] = __uint_as_float(t.z & 0xffff0000u); v[2 * i + 1][2] = __uint_as_float(t.w << 16); v[2 * i + 1][3] = __uint_as_float(t.w & 0xffff0000u); }
#pragma unroll
        for (int i = 0; i < 4; ++i) ss += v[i][0] * v[i][0] + v[i][1] * v[i][1] + v[i][2] * v[i][2] + v[i][3] * v[i][3];
#pragma unroll
        for (int o = 32; o >= 1; o >>= 1) ss += xshfl(ss, lane, o);
        const float rs = rsqrtf(ss * (1.f / 1024.f) + EPSV);
#pragma unroll
        for (int i = 0; i < 2; ++i) { const int c0 = 8 * (lane + 64 * i);
            *(f32x4*)(outf + (size_t)row * 1024 + c0) = v[2 * i] * rs * *(const f32x4*)(g + c0);
            *(f32x4*)(outf + (size_t)row * 1024 + c0 + 4) = v[2 * i + 1] * rs * *(const f32x4*)(g + c0 + 4); }
    }
}

#define MFMA32(a, b, c) __builtin_amdgcn_mfma_f32_32x32x16_bf16(a, b, c, 0, 0, 0)
__device__ __forceinline__ bf16x8 mk8(u32x2 a, u32x2 b) { u32x4 t; t.x = a.x; t.y = a.y; t.z = b.x; t.w = b.y; return __builtin_bit_cast(bf16x8, t); }
typedef float f32x8v __attribute__((ext_vector_type(8)));
typedef float f32x2v __attribute__((ext_vector_type(2)));
__device__ __forceinline__ void softmax_pv(const f32x16& s, f32x16& o0, f32x16& o1, float& m, float& l, const bf16x8 v00, const bf16x8 v01, const bf16x8 v10, const bf16x8 v11, int lane, bool& fresh) {
    if (fresh) {
        float mx = s[0];
#pragma unroll
        for (int i = 1; i < 16; ++i) mx = fmaxf(mx, s[i]);
        mx = fmaxf(mx, xshfl(mx, lane, 32));
        m = fmaxf(mx, -16.f);
        fresh = false;
    }
    const f32x16 t = s - m;
    f32x16 p;
#pragma unroll
    for (int i = 0; i < 16; ++i) p[i] = fexp2(t[i]);
    const f32x8v a8 = p.lo + p.hi; const f32x4 a4 = a8.lo + a8.hi; const f32x2v a2 = a4.lo + a4.hi;
    l += a2.x + a2.y;
    u32x4 a, b;
    a.x = cvt_pk_bf16(p[0], p[1]); a.y = cvt_pk_bf16(p[2], p[3]); a.z = cvt_pk_bf16(p[4], p[5]); a.w = cvt_pk_bf16(p[6], p[7]);
    b.x = cvt_pk_bf16(p[8], p[9]); b.y = cvt_pk_bf16(p[10], p[11]); b.z = cvt_pk_bf16(p[12], p[13]); b.w = cvt_pk_bf16(p[14], p[15]);
    const bf16x8 pk0 = __builtin_bit_cast(bf16x8, a), pk1 = __builtin_bit_cast(bf16x8, b);
    o0 = MFMA32(v00, pk0, o0); o0 = MFMA32(v01, pk1, o0);
    o1 = MFMA32(v10, pk0, o1); o1 = MFMA32(v11, pk1, o1);
}
__device__ __forceinline__ void attn_store(int lane, const f32x16& o0, const f32x16& o1, float l, bf16_t* op  ) {
    const float inv = 1.f / (l + xshfl(l, lane, 32));
#pragma unroll
    for (int g = 0; g < 4; ++g) {
        u32x2 a, b;
        a.x = cvt_pk_bf16(o0[4 * g] * inv, o0[4 * g + 1] * inv); a.y = cvt_pk_bf16(o0[4 * g + 2] * inv, o0[4 * g + 3] * inv);
        b.x = cvt_pk_bf16(o1[4 * g] * inv, o1[4 * g + 1] * inv); b.y = cvt_pk_bf16(o1[4 * g + 2] * inv, o1[4 * g + 3] * inv);
        *(u32x2*)(op + 8 * g) = a; *(u32x2*)(op + 32 + 8 * g) = b;
    }
}
__device__ __forceinline__ void load_vt(const bf16_t* vrow, bf16x8& v00, bf16x8& v01, bf16x8& v10, bf16x8& v11) {
    v00 = mk8(*(const u32x2*)(vrow), *(const u32x2*)(vrow + 8)); v01 = mk8(*(const u32x2*)(vrow + 16), *(const u32x2*)(vrow + 24));
    const bf16_t* v1 = vrow + 32 * 2048;
    v10 = mk8(*(const u32x2*)(v1), *(const u32x2*)(v1 + 8)); v11 = mk8(*(const u32x2*)(v1 + 16), *(const u32x2*)(v1 + 24));
}

#define LASP PG8_LAS unsigned char*
__device__ __forceinline__ void read_vtr(LASP vimg, int keyoff, int lane, bf16x8& v00, bf16x8& v01, bf16x8& v10, bf16x8& v11) {
    LASP base = vimg + (keyoff + 4 * (lane >> 5) + ((lane & 15) >> 2)) * 144 + (16 * ((lane >> 4) & 1) + 4 * (lane & 3)) * 2;
    bf16x8 f[2][2];
#pragma unroll
    for (int dt = 0; dt < 2; ++dt)
#pragma unroll
        for (int s = 0; s < 2; ++s) {
            const s16x4 lo = __builtin_amdgcn_ds_read_tr16_b64_v4i16((PG8_LAS s16x4*)(base + (16 * s) * 144 + 64 * dt));
            const s16x4 hi = __builtin_amdgcn_ds_read_tr16_b64_v4i16((PG8_LAS s16x4*)(base + (16 * s + 8) * 144 + 64 * dt));
            bf16x8 g; g[0] = lo[0]; g[1] = lo[1]; g[2] = lo[2]; g[3] = lo[3]; g[4] = hi[0]; g[5] = hi[1]; g[6] = hi[2]; g[7] = hi[3]; f[dt][s] = g; }
    v00 = f[0][0]; v01 = f[0][1]; v10 = f[1][0]; v11 = f[1][1];
}
template <int KD> struct StageCfg { static constexpr int KP = KD * 2 + 16, KBYTES = 64 * KP, VP = 136, VBYTES = 64 * VP, BYTES = KBYTES + VBYTES; };
struct StageRegs { u32x4 k, v, pe; };
template <int KD>
__device__ __forceinline__ void stage_issue(StageRegs& R, const bf16_t* __restrict__ krow0, int kstride, const bf16_t* __restrict__ pe0, const bf16_t* __restrict__ vt0, int tid) {
    R.k = *(const u32x4*)(krow0 + (size_t)(tid >> 3) * kstride + (tid & 7) * 8);
    R.v = *(const u32x4*)(vt0 + (size_t)(tid >> 3) * 2048 + (tid & 7) * 8);
    if (KD == 96) R.pe = *(const u32x4*)(pe0 + ((tid >> 2) & 63) * 32 + (tid & 3) * 8);
}
template <int KD>
__device__ __forceinline__ void stage_commit(LASP buf, const StageRegs& R, int tid) {
    typedef StageCfg<KD> C;
    *(PG8_LAS u32x4*)(buf + (tid >> 3) * C::KP + (tid & 7) * 16) = R.k;
    LASP vp = buf + C::KBYTES + (tid >> 3) * C::VP + (tid & 7) * 16;
    u32x2 a, b; a.x = R.v.x; a.y = R.v.y; b.x = R.v.z; b.y = R.v.w;
    *(PG8_LAS u32x2*)vp = a; *(PG8_LAS u32x2*)(vp + 8) = b;
    if (KD == 96) { if (tid < 256) *(PG8_LAS u32x4*)(buf + (tid >> 2) * C::KP + 128 + (tid & 3) * 16) = R.pe; }
}
template <int KD>
__device__ __forceinline__ void read_kf(LASP buf, int row, int h, bf16x8 (&kf)[KD / 16]) {
#pragma unroll
    for (int kk = 0; kk < KD / 16; ++kk) kf[kk] = *(const PG8_LAS bf16x8*)(buf + row * StageCfg<KD>::KP + 32 * kk + 16 * h);
}
__device__ __forceinline__ void read_vf(LASP vbuf, int r, int keyoff, bf16x8& v00, bf16x8& v01, bf16x8& v10, bf16x8& v11) {
    LASP p0 = vbuf + r * 136 + keyoff * 2; LASP p1 = p0 + 32 * 136;
    v00 = mk8(*(const PG8_LAS u32x2*)(p0), *(const PG8_LAS u32x2*)(p0 + 16)); v01 = mk8(*(const PG8_LAS u32x2*)(p0 + 32), *(const PG8_LAS u32x2*)(p0 + 48));
    v10 = mk8(*(const PG8_LAS u32x2*)(p1), *(const PG8_LAS u32x2*)(p1 + 16)); v11 = mk8(*(const PG8_LAS u32x2*)(p1 + 32), *(const PG8_LAS u32x2*)(p1 + 48));
}


template <int KD, int PD, bool ALWAYS, class Src, class Comp>
__device__ __forceinline__ void staged_loop(LASP lds, int s_lo, int s_hi, int tid, Src&& src, Comp&& comp) {
    typedef StageCfg<KD> C;
    if (s_lo >= s_hi) return;
    StageRegs R[PD];
    src(s_lo, R[0]); stage_commit<KD>(lds + (s_lo & 1) * C::BYTES, R[0], tid);
#pragma unroll
    for (int d = 1; d < PD; ++d) { if (ALWAYS) src(s_lo + d < s_hi ? s_lo + d : s_hi - 1, R[d]); else if (s_lo + d < s_hi) src(s_lo + d, R[d]); }
    __syncthreads();
    for (int st = s_lo; st < s_hi; st += PD) {
#pragma unroll
        for (int d = 0; d < PD; ++d) {
            const int s = st + d;
            if (s < s_hi) {
                if (ALWAYS) src(s + PD < s_hi ? s + PD : s_hi - 1, R[d]); else if (s + PD < s_hi) src(s + PD, R[d]);
                comp(s, lds + (s & 1) * C::BYTES);
                if (s + 1 < s_hi) stage_commit<KD>(lds + ((s + 1) & 1) * C::BYTES, R[(d + 1) % PD], tid);
                __syncthreads();
            }
        }
    }
}

__device__ __forceinline__ void mla_phase(LASP lds, const bf16_t* __restrict__ QA, const bf16_t* __restrict__ KA, const bf16_t* __restrict__ KPE, const bf16_t* __restrict__ VAT, bf16_t* O, int tid) {
    constexpr int KB_ = 64 * 208, SB = KB_ + 64 * 144 + 2 * 1024;
    const int lane = tid & 63, w = __builtin_amdgcn_readfirstlane(tid >> 6), r = lane & 31, h = lane >> 5;
    if (w >= 4) __builtin_amdgcn_s_setprio(1);
    for (int it = blockIdx.x; it < 1024; it += gridDim.x) {
        int item = it;
        if (gridDim.x == 256) { const int k = it >> 8, B = it & 255, x = B & 7, y = B >> 3; item = ((((k * 8 + x) * 4) + (y >> 3)) << 3) | (y & 7); }
        const int bh = item >> 3, qb8 = item & 7, b = bh >> 3, head = bh & 7;
        const size_t tq = (size_t)b * 2048 + qb8 * 256 + w * 32 + r;
        bf16x8 qf[6];
#pragma unroll
        for (int kk = 0; kk < 6; ++kk) qf[kk] = *(const bf16x8*)(QA + tq * 768 + head * 96 + 16 * kk + 8 * h);
        const char* src[3]; unsigned step[3]; int dst[3];
#pragma unroll
        for (int j = 0; j < 3; ++j) {
            const int p = w + 8 * j;
            if (p < 13) { const int c = 64 * p + lane, row = c / 13, col = c - 13 * row;
                if (col >= 8 && col < 12) { src[j] = (const char*)(KPE + ((size_t)b * 2048 + row) * 32 + (col - 8) * 8); step[j] = 64 * 32 * 2; }
                else { src[j] = (const char*)(KA + ((size_t)b * 2048 + row) * 512 + head * 64 + (col & 7) * 8); step[j] = 64 * 512 * 2; }
                dst[j] = p * 1024; }
            else if (p < 22) { const int c = 64 * (p - 13) + lane, row = c / 9, col = c - 9 * row;
                src[j] = (const char*)(VAT + ((size_t)b * 2048 + row) * 512 + head * 64 + (col & 7) * 8); step[j] = 64 * 512 * 2; dst[j] = KB_ + (p - 13) * 1024; }
            else { src[j] = (const char*)(KA + ((size_t)b * 2048 + lane) * 512); step[j] = 0; dst[j] = KB_ + 64 * 144 + (p - 22) * 1024; }
        }
        f32x16 o0, o1;
#pragma unroll
        for (int i = 0; i < 16; ++i) { o0[i] = 0.f; o1[i] = 0.f; }
        float m = 0.f, l = 0.f; bool fresh = true;
#define MLA_ISSUE(st) do { const int _s = (st) < 32 ? (st) : 31; LASP _b = lds + ((st) % 5) * SB; _Pragma("unroll") for (int _j = 0; _j < 3; ++_j) \
        __builtin_amdgcn_global_load_lds((const unsigned*)(src[_j] + (size_t)_s * step[_j]), (PG8_LAS unsigned*)(_b + dst[_j]), 16, 0, 0); } while (0)
        asm volatile("s_waitcnt vmcnt(0) lgkmcnt(0)" ::: "memory"); __builtin_amdgcn_s_barrier();
        MLA_ISSUE(0); MLA_ISSUE(1); MLA_ISSUE(2); MLA_ISSUE(3);
        for (int st = 0; st < 32; ++st) {
            asm volatile("s_waitcnt vmcnt(9)" ::: "memory");
            __builtin_amdgcn_s_barrier();
            asm volatile("" ::: "memory");
            MLA_ISSUE(st + 4);
            LASP buf = lds + (st % 5) * SB;
#pragma unroll
            for (int sub = 0; sub < 2; ++sub) {
                bf16x8 kf[6], v00, v01, v10, v11;
#pragma unroll
                for (int kk = 0; kk < 6; ++kk) kf[kk] = *(const PG8_LAS bf16x8*)(buf + (32 * sub + r) * 208 + 32 * kk + 16 * h);
                read_vtr(buf + KB_, 32 * sub, lane, v00, v01, v10, v11);
                __builtin_amdgcn_sched_barrier(0);
                f32x16 s;
#pragma unroll
                for (int i = 0; i < 16; ++i) s[i] = 0.f;
#pragma unroll
                for (int kk = 0; kk < 6; ++kk) s = MFMA32(kf[kk], qf[kk], s);
                softmax_pv(s, o0, o1, m, l, v00, v01, v10, v11, lane, fresh);
            }
        }
#undef MLA_ISSUE
        attn_store(lane, o0, o1, l, O + tq * 1024 + head * 64 + 4 * h);
    }
    __builtin_amdgcn_s_setprio(0);
    asm volatile("s_waitcnt vmcnt(0)" ::: "memory"); __syncthreads();
}


constexpr int D64_KB = 64 * 144, D64_SB = 2 * D64_KB + 1024;
template <int NBUF, class Comp>
__device__ __forceinline__ void dma64_loop(LASP lds, int s_lo, int s_hi, const bf16_t* kbase  , int kstride, const bf16_t* vbase  , int w, int lane, Comp&& comp) {
    const char* src[3]; unsigned step[3]; int dst[3];
#pragma unroll
    for (int j = 0; j < 3; ++j) {
        const int p = w + 8 * j;
        if (p < 9) { const int c = 64 * p + lane, row = c / 9, col = c - 9 * row; src[j] = (const char*)(kbase + (size_t)row * kstride + (col & 7) * 8); step[j] = (unsigned)(64 * kstride * 2); dst[j] = p * 1024; }
        else if (p < 18) { const int c = 64 * (p - 9) + lane, row = c / 9, col = c - 9 * row; src[j] = (const char*)(vbase + (size_t)row * kstride + (col & 7) * 8); step[j] = (unsigned)(64 * kstride * 2); dst[j] = D64_KB + (p - 9) * 1024; }
        else { src[j] = (const char*)(kbase + (size_t)lane * kstride); step[j] = 0u; dst[j] = 2 * D64_KB; }
    }
#define D64_ISSUE(st) do { const int _s = (st) < s_hi ? (st) : s_hi - 1; LASP _b = lds + (((st) - s_lo) % NBUF) * D64_SB; _Pragma("unroll") for (int _j = 0; _j < 3; ++_j) \
        __builtin_amdgcn_global_load_lds((const unsigned*)(src[_j] + (size_t)_s * step[_j]), (PG8_LAS unsigned*)(_b + dst[_j]), 16, 0, 0); } while (0)
    asm volatile("s_waitcnt vmcnt(0) lgkmcnt(0)" ::: "memory"); __builtin_amdgcn_s_barrier();
#pragma unroll
    for (int d = 0; d < NBUF - 1; ++d) D64_ISSUE(s_lo + d);
    for (int st = s_lo; st < s_hi; ++st) {
        if (NBUF == 5) asm volatile("s_waitcnt vmcnt(9)" ::: "memory"); else if (NBUF == 4) asm volatile("s_waitcnt vmcnt(6)" ::: "memory"); else asm volatile("s_waitcnt vmcnt(3)" ::: "memory");
        __builtin_amdgcn_s_barrier();
        asm volatile("" ::: "memory");
        D64_ISSUE(st + NBUF - 1);
        comp(st, lds + ((st - s_lo) % NBUF) * D64_SB);
    }
#undef D64_ISSUE
    asm volatile("s_waitcnt vmcnt(0)" ::: "memory"); __builtin_amdgcn_s_barrier();
}
__device__ __forceinline__ void d64_read(LASP buf, int krow, int lane, int keyoff, int h, bf16x8 (&kf)[4], bf16x8& v00, bf16x8& v01, bf16x8& v10, bf16x8& v11) {
#pragma unroll
    for (int kk = 0; kk < 4; ++kk) kf[kk] = *(const PG8_LAS bf16x8*)(buf + krow * 144 + 32 * kk + 16 * h);
    read_vtr(buf + D64_KB, keyoff, lane, v00, v01, v10, v11);
}

__device__ __forceinline__ void dil_phase(LASP lds, const bf16_t* __restrict__ QB, const bf16_t* __restrict__ KB, const bf16_t* __restrict__ VBT, const bf16_t* __restrict__ VB, bf16_t* O, int tid) {
    typedef StageCfg<64> C;
    const int lane = tid & 63, w = tid >> 6, r = lane & 31, h = lane >> 5;
    LASP wsc = lds + 4 * D64_SB + w * 4608;
    if (__builtin_amdgcn_readfirstlane(tid >> 6) >= 4) __builtin_amdgcn_s_setprio(1);
    for (int it = blockIdx.x; it < 1024; it += gridDim.x) {
        int item = it;
        if (gridDim.x == 256) { const int k = it >> 8, B = it & 255, x = B & 7, y = B >> 3; item = ((((k * 8 + x) * 4) + (y >> 3)) << 3) | (y & 7); }
        const int bh = item >> 3, a = (item >> 1) & 3, rr = 8 * (item & 1) + w, b = bh >> 3, head = bh & 7;
        const int tq = 512 * a + rr + 16 * r;
        bf16x8 qf[4];
#pragma unroll
        for (int kk = 0; kk < 4; ++kk) qf[kk] = *(const bf16x8*)(QB + ((size_t)b * 2048 + tq) * 512 + head * 64 + 16 * kk + 8 * h);
        f32x16 o0, o1;
#pragma unroll
        for (int i = 0; i < 16; ++i) { o0[i] = 0.f; o1[i] = 0.f; }
        float m = 0.f, l = 0.f; bool fresh = true;
        {
            const int s_lo = a == 0 ? 1 : 0, s_hi = a == 3 ? 9 : 10;
            const bf16_t* k0 = KB + ((size_t)b * 2048 + 512 * a - 64) * 512 + head * 64;
            const bf16_t* vt0 = VB + ((size_t)b * 2048 + 512 * a - 64) * 512 + head * 64;
            dma64_loop<4>(lds, s_lo, s_hi, k0, 512, vt0, __builtin_amdgcn_readfirstlane(w), lane, [&](int st, LASP buf) {
#pragma unroll
                for (int sub = 0; sub < 2; ++sub) {
                    bf16x8 kf[4], v00, v01, v10, v11;
                    d64_read(buf, 32 * sub + r, lane, 32 * sub, h, kf, v00, v01, v10, v11);
                    f32x16 s;
#pragma unroll
                    for (int i = 0; i < 16; ++i) s[i] = 0.f;
#pragma unroll
                    for (int kk = 0; kk < 4; ++kk) s = MFMA32(kf[kk], qf[kk], s);
                    const int base = 512 * a - 64 + 64 * st + 32 * sub + 4 * h - tq;
#pragma unroll
                    for (int i = 0; i < 16; ++i) { const int dd = base + 8 * (i >> 2) + (i & 3); s[i] = (dd <= 64 && dd >= -64) ? s[i] : -__builtin_inff(); }
                    softmax_pv(s, o0, o1, m, l, v00, v01, v10, v11, lane, fresh);
                }
            });
        }
        {
            const bf16_t* kb = KB + (size_t)b * 2048 * 512 + head * 64 + 8 * h;
            const bf16_t* vb = VB + (size_t)b * 2048 * 512 + head * 64 + 8 * h;
            auto tile_ok = [&](int t) -> bool { const int u0 = t < 8 ? 128 * a - 64 + 32 * t : 32 * a - 64 + 32 * (t - 8); return u0 >= 0 && u0 < (t < 8 ? 512 : 128); };
            auto tile_pos = [&](int t) -> int { return t < 8 ? 4 * (128 * a - 64 + 32 * t + r) + (rr & 3) : 16 * (32 * a - 64 + 32 * (t - 8) + r) + rr; };
            int t = 0; while (t < 13 && !tile_ok(t)) ++t;
            u32x4 kc[4], vc[4];
            if (t < 13) { const size_t kp = (size_t)tile_pos(t) * 512;
#pragma unroll
                for (int kk = 0; kk < 4; ++kk) { kc[kk] = *(const u32x4*)(kb + kp + 16 * kk); vc[kk] = *(const u32x4*)(vb + kp + 16 * kk); } }
            while (t < 13) {
                int tn = t + 1; while (tn < 13 && !tile_ok(tn)) ++tn;
                u32x4 kn[4], vn[4];
                if (tn < 13) { const size_t kp = (size_t)tile_pos(tn) * 512;
#pragma unroll
                    for (int kk = 0; kk < 4; ++kk) { kn[kk] = *(const u32x4*)(kb + kp + 16 * kk); vn[kk] = *(const u32x4*)(vb + kp + 16 * kk); } }
#pragma unroll
                for (int kk = 0; kk < 4; ++kk) *(PG8_LAS u32x4*)(wsc + r * 144 + 32 * kk + 16 * h) = vc[kk];
                __builtin_amdgcn_wave_barrier();
                f32x16 s;
#pragma unroll
                for (int i = 0; i < 16; ++i) s[i] = 0.f;
#pragma unroll
                for (int kk = 0; kk < 4; ++kk) s = MFMA32(__builtin_bit_cast(bf16x8, kc[kk]), qf[kk], s);
                bf16x8 vv[2][2];
#pragma unroll
                for (int dt = 0; dt < 2; ++dt)
#pragma unroll
                    for (int sx = 0; sx < 2; ++sx) {
                        const s16x4 lo = __builtin_amdgcn_ds_read_tr16_b64_v4i16((PG8_LAS s16x4*)(wsc + (16 * sx + 4 * h + ((lane & 15) >> 2)) * 144 + (32 * dt + 16 * ((lane >> 4) & 1) + 4 * (lane & 3)) * 2));
                        const s16x4 hi = __builtin_amdgcn_ds_read_tr16_b64_v4i16((PG8_LAS s16x4*)(wsc + (16 * sx + 8 + 4 * h + ((lane & 15) >> 2)) * 144 + (32 * dt + 16 * ((lane >> 4) & 1) + 4 * (lane & 3)) * 2));
                        bf16x8 f; f[0] = lo[0]; f[1] = lo[1]; f[2] = lo[2]; f[3] = lo[3]; f[4] = hi[0]; f[5] = hi[1]; f[6] = hi[2]; f[7] = hi[3];
                        vv[dt][sx] = f; }
                __builtin_amdgcn_wave_barrier();
                const int base = (t < 8 ? 128 * a - 64 + 32 * t - (128 * a + (rr >> 2) + 4 * r) : 32 * a - 64 + 32 * (t - 8) - (32 * a + r)) + 4 * h;
#pragma unroll
                for (int i = 0; i < 16; ++i) { const int dd = base + 8 * (i >> 2) + (i & 3); s[i] = (dd <= 64 && dd >= -64) ? s[i] : -__builtin_inff(); }
                softmax_pv(s, o0, o1, m, l, vv[0][0], vv[0][1], vv[1][0], vv[1][1], lane, fresh);
#pragma unroll
                for (int kk = 0; kk < 4; ++kk) { kc[kk] = kn[kk]; vc[kk] = vn[kk]; }
                t = tn;
            }
        }
        attn_store(lane, o0, o1, l, O + ((size_t)b * 2048 + tq) * 1024 + 512 + head * 64 + 4 * h);
        __syncthreads();
    }
    __builtin_amdgcn_s_setprio(0);
}

__device__ __forceinline__ int clampi(int v, int lo, int hi) { return v < lo ? lo : (v > hi ? hi : v); }
__device__ __forceinline__ void na_phase(LASP lds, const bf16_t* __restrict__ QC, const bf16_t* __restrict__ KC, const bf16_t* __restrict__ VCT, const float* __restrict__ rpb, bf16_t* O, int tid) {
    typedef StageCfg<64> C;
    const int lane = tid & 63, w = tid >> 6, r = lane & 31, h = lane >> 5;
    PG8_LAS float* btab = (PG8_LAS float*)(lds + 5 * D64_SB + 256);
    if (__builtin_amdgcn_readfirstlane(tid >> 6) >= 4) __builtin_amdgcn_s_setprio(1);
    for (int it = blockIdx.x; it < 2048; it += gridDim.x) {
        int item = it;
        if (gridDim.x == 256) { const int k = it >> 8, B = it & 255, x = B & 7, y = B >> 3; item = ((((k * 8 + x) * 4) + (y >> 3)) << 3) | (y & 7); }
        const int bh = item >> 3, rg = item & 7, b = bh >> 4, head = bh & 15;
        const int rp = 2 * rg + (w >> 2), j = w & 3;
        const int qrow = 2 * rp + (r >> 4), qcol = 16 * j + (r & 15), tq = qrow * 64 + qcol;
        bf16x8 qf[4];
#pragma unroll
        for (int kk = 0; kk < 4; ++kk) qf[kk] = *(const bf16x8*)(QC + ((size_t)b * 2048 + tq) * 1024 + head * 64 + 16 * kk + 8 * h);
        const int rs_q = clampi(qrow - 4, 0, 24), cs_q = clampi(qcol - 8, 0, 48), band = clampi(16 * j - 8, 0, 32);
        const int kr_lo = clampi(4 * rg - 4, 0, 24), nst = clampi(4 * rg - 1, 0, 24) + 8 - kr_lo;
        const int wlo = clampi(2 * rp - 4, 0, 24), whi = clampi(2 * rp - 3, 0, 24) + 8;
        const int cbase = band + 4 * h - qcol + 15;
        float cadd[16];
#pragma unroll
        for (int i = 0; i < 16; ++i) { const int kc = band + 8 * (i >> 2) + 4 * h + (i & 3); cadd[i] = (kc >= cs_q && kc < cs_q + 16) ? 0.f : -__builtin_inff(); }
        const bf16_t* k0 = KC + ((size_t)b * 2048 + kr_lo * 64) * 1024 + head * 64;
        const bf16_t* vt0 = VCT + ((size_t)b * 2048 + kr_lo * 64) * 1024 + head * 64;
        f32x16 o0, o1;
#pragma unroll
        for (int i = 0; i < 16; ++i) { o0[i] = 0.f; o1[i] = 0.f; }
        float m = 0.f, l = 0.f; bool fresh = true;
        asm volatile("s_waitcnt lgkmcnt(0)" ::: "memory"); __builtin_amdgcn_s_barrier();
        btab[tid] = tid < 465 ? rpb[head * 465 + tid] * LOG2E : 0.f;
        if (tid < 16) btab[tid - 16] = 0.f;
        dma64_loop<5>(lds, 0, nst, k0, 1024, vt0, __builtin_amdgcn_readfirstlane(w), lane, [&](int st, LASP buf) {
            const int kr = kr_lo + st;
            if (kr >= wlo && kr < whi) {
                bf16x8 kf[4], v00, v01, v10, v11;
                d64_read(buf, band + r, lane, band, h, kf, v00, v01, v10, v11);
                f32x16 s;
#pragma unroll
                for (int i = 0; i < 16; ++i) s[i] = 0.f;
#pragma unroll
                for (int kk = 0; kk < 4; ++kk) s = MFMA32(kf[kk], qf[kk], s);
                const float radd = ((kr >= rs_q) && (kr < rs_q + 8)) ? 0.f : -__builtin_inff();
                const PG8_LAS float* bp = btab + clampi(kr - qrow + 7, 0, 14) * 31 + cbase;
#pragma unroll
                for (int i = 0; i < 16; ++i) s[i] = s[i] + (bp[8 * (i >> 2) + (i & 3)] + cadd[i]) + radd;
                softmax_pv(s, o0, o1, m, l, v00, v01, v10, v11, lane, fresh);
            }
        });
        attn_store(lane, o0, o1, l, O + ((size_t)b * 2048 + tq) * 1024 + head * 64 + 4 * h);
    }
    __builtin_amdgcn_s_setprio(0);
}

__device__ __forceinline__ int my_tid(int wid_s) { unsigned z = 0u; asm volatile("" : "+s"(z)); return wid_s * 64 + (int)__builtin_amdgcn_mbcnt_hi(~0u, __builtin_amdgcn_mbcnt_lo(~0u, z)); }
__global__ void __launch_bounds__(512, 2) fwd_kernel(Params p) {
    extern __shared__ __attribute__((aligned(16))) unsigned char shm[];
    cg::grid_group grid = cg::this_grid();
    PG8_LAS unsigned char* lds = (PG8_LAS unsigned char*)shm;
    const int tid = threadIdx.x, lane = tid & 63, wid = tid >> 6;
    const int wid_s = __builtin_amdgcn_readfirstlane(wid);
    const unsigned xcc = xb_xcc_id();
    if (tid < 4) ((volatile PG8_LAS unsigned*)(lds + pg8::STAGE_BYTES))[tid] = 0u;
    if (tid == 0) (void)xb_add((unsigned*)(p.ws + WS_BAR) + XB_XCNT(xcc), 1u);
    __syncthreads();
    const int gw = blockIdx.x * 8 + wid, nw = gridDim.x * 8;

    for (int rep0 = 0; rep0 < NREP(10); ++rep0)
    {
        unsigned char* ws = p.ws; float* cosA = (float*)(ws + WS_COSA); float* sinA = (float*)(ws + WS_SINA); float* cosB = (float*)(ws + WS_COSB); float* sinB = (float*)(ws + WS_SINB); bf16_t* XN = (bf16_t*)(ws + WS_XN);
        float* tl = (float*)shm;
        for (int i = 0; i < 2; ++i) {
            prep_w(tl, p.in[2] + (size_t)i * 1024 * 1952, 1952, 1024, p.in[1] + i * 1024, (bf16_t*)(ws + W_IN + i * SZ_IN), 1024, 0, 0, 2048, MAP_EVIN, 0);
            prep_w(tl, p.in[4] + (size_t)i * 256 * 768, 768, 256, p.in[3] + i * 256, (bf16_t*)(ws + W_UP + i * SZ_UP), 384, 0, 0, 768, MAP_QUP, 0);
            prep_w(tl, p.in[6] + (size_t)i * 128 * 1024, 1024, 128, p.in[5] + i * 128, (bf16_t*)(ws + W_UP + i * SZ_UP), 384, 256, 768, 1024, MAP_KVUP, 0);
            prep_w(tl, p.in[7] + (size_t)i * 1024 * 1024, 1024, 1024, nullptr, (bf16_t*)(ws + W_EOUT + i * SZ_EOUT), 1024, 0, 0, 1024, MAP_P32, 0);
            prep_w(tl, p.in[9] + (size_t)i * 1024 * 3072, 3072, 1024, p.in[8] + i * 1024, (bf16_t*)(ws + W_QKV + i * SZ_QKV), 1024, 0, 0, 3072, MAP_ODQKV, 0);
            prep_w(tl, p.in[11] + (size_t)i * 1024 * 1024, 1024, 1024, nullptr, (bf16_t*)(ws + W_OOUT + i * SZ_OOUT), 1024, 0, 0, 1024, MAP_P32, 0);
        }
        for (int L = 0; L < 4; ++L) {
            prep_w(tl, p.in[13] + (size_t)L * 1024 * 2816, 2816, 1024, p.in[12] + L * 1024, (bf16_t*)(ws + W_GU + L * SZ_GU), 1024, 0, 0, 5632, MAP_GU, 0);
            prep_w(tl, p.in[14] + (size_t)L * 1024 * 2816, 2816, 1024, p.in[12] + L * 1024, (bf16_t*)(ws + W_GU + L * SZ_GU), 1024, 0, 0, 5632, MAP_GU, 1);
            prep_w(tl, p.in[15] + (size_t)L * 2816 * 1024, 1024, 2816, nullptr, (bf16_t*)(ws + W_DN + L * SZ_DN), 2816, 0, 0, 1024, MAP_P32, 0);
        }
        for (int idx = blockIdx.x * 512 + tid; idx < 2048 * 32; idx += gridDim.x * 512) {
            const int pos = idx >> 5, i = idx & 31; const float inv = powf(10000.f, -(float)(2 * i) / 64.f), ang = (float)pos * inv;
            cosB[idx] = cosf(ang); sinB[idx] = sinf(ang);
            if (i < 16) { const float inva = powf(10000.f, -(float)(2 * i) / 32.f), anga = (float)pos * inva; cosA[pos * 16 + i] = cosf(anga); sinA[pos * 16 + i] = sinf(anga); }
        }
        float* nssq = (float*)(ws + WS_NSSQ);
        norm_phase(p.in[0], XN, nullptr, nullptr, nssq, gw, nw, lane);
    }
    grid.sync();

    for (int ph = 0; ph < 30 + EXTRA_N; ++ph) {
        const int lp = ph < 30 ? ph / 15 : 1, q = ph < 30 ? ph - 15 * lp : EXTRA_Q;
        __attribute__((address_space(1))) unsigned char* ws_g = (__attribute__((address_space(1))) unsigned char*)p.ws; asm volatile("" : "+s"(ws_g)); unsigned char* ws = (unsigned char*)ws_g;
        bf16_t* XN = (bf16_t*)(ws + WS_XN); bf16_t* O = (bf16_t*)(ws + WS_O); bf16_t* HFF = (bf16_t*)(ws + R_HFF);
        if (EN(0) && q == 0) {
            pg8::Gemm g{XN, (const bf16_t*)(ws + W_IN + lp * SZ_IN), T_, 2048, 1024};
            pg8::StaticOrder S; S.init(g.M, g.N, (int)gridDim.x, (int)blockIdx.x);
            EpiEvenIn E{ws, (const float*)(ws + WS_NSSQ)};
            pg8::gemm_phase<EpiEvenIn, pg8::StaticOrder, false>(lds, g, S, E, nullptr, my_tid(wid_s));
        } else if (EN(1) && q == 1) {
            pg8::Gemm g{(const bf16_t*)(ws + R_A2), (const bf16_t*)(ws + W_UP + lp * SZ_UP), T_, 1792, 384};
            pg8::StaticOrder S; S.init(g.M, g.N, (int)gridDim.x, (int)blockIdx.x);
            EpiEvenUp E{ws};
            pg8::gemm_phase<EpiEvenUp, pg8::StaticOrder, false>(lds, g, S, E, nullptr, my_tid(wid_s));
            dil_phase(lds, (const bf16_t*)(ws + R_QB), (const bf16_t*)(ws + R_KB), (const bf16_t*)(ws + R_VBT), (const bf16_t*)(ws + R_VB), O, my_tid(wid_s));
        } else if (EN(2) && q == 2) {
            const int t2 = my_tid(wid_s);
            { int nrep = NREP(8); asm volatile("" : "+s"(nrep)); for (int rep = 0; rep < nrep; ++rep)
                mla_phase(lds, (const bf16_t*)(ws + R_QA), (const bf16_t*)(ws + R_KA), (const bf16_t*)(ws + R_KPE), (const bf16_t*)(ws + R_VAT), O, t2); }
        } else if (EN(3) && (q == 3 || q == 6 || q == 10 || q == 13)) {
            const bool dn = (q == 6 || q == 13);
            const bf16_t* Bt = q == 3 ? (const bf16_t*)(ws + W_EOUT + lp * SZ_EOUT) : q == 10 ? (const bf16_t*)(ws + W_OOUT + lp * SZ_OOUT) : (const bf16_t*)(ws + W_DN + (2 * lp + (q == 13)) * SZ_DN);
            pg8::Gemm g{dn ? HFF : O, Bt, T_, 1024, dn ? 2816 : 1024};
            pg8::StaticOrder S; S.init(g.M, g.N, (int)gridDim.x, (int)blockIdx.x);
            EpiResid E{ph == 3 ? p.in[0] : nullptr, XN, (float*)(ws + WS_NSSQ)};
            pg8::gemm_phase<EpiResid, pg8::StaticOrder, false>(lds, g, S, E, nullptr, my_tid(wid_s));
        } else if (q == 4 || q == 7 || q == 11 || q == 14) {
            if (ph != 29) continue;
            const int t2 = my_tid(wid_s), lane = t2 & 63, gw = blockIdx.x * 8 + (t2 >> 6);
            final_norm_phase(XN, p.out, p.in[16], gw, nw, lane);
        } else if (EN(5) && (q == 5 || q == 12)) {
            pg8::Gemm g{XN, (const bf16_t*)(ws + W_GU + (2 * lp + (q == 12)) * SZ_GU), T_, 5632, 1024};
            pg8::StaticOrder S; S.init(g.M, g.N, (int)gridDim.x, (int)blockIdx.x);
            EpiGateUp E{HFF, (const float*)(ws + WS_NSSQ)};
            pg8::gemm_phase<EpiGateUp, pg8::StaticOrder, false>(lds, g, S, E, nullptr, my_tid(wid_s));
        } else if (EN(6) && q == 8) {
            pg8::Gemm g{XN, (const bf16_t*)(ws + W_QKV + lp * SZ_QKV), T_, 3072, 1024};
            pg8::StaticOrder S; S.init(g.M, g.N, (int)gridDim.x, (int)blockIdx.x);
            EpiOddQKV E{ws, (const float*)(ws + WS_NSSQ)};
            pg8::gemm_phase<EpiOddQKV, pg8::StaticOrder, false>(lds, g, S, E, nullptr, my_tid(wid_s));
        } else if (EN(7) && q == 9) {
            const int t2 = my_tid(wid_s);
            int nrep = NREP(7); asm volatile("" : "+s"(nrep));
            for (int rep = 0; rep < nrep; ++rep) na_phase(lds, (const bf16_t*)(ws + R_QC), (const bf16_t*)(ws + R_KC), (const bf16_t*)(ws + R_VCT), p.in[10] + (size_t)lp * 16 * 465, O, t2);
        }
        if (ph != 29 + EXTRA_N) { int nrep = NREP(11); asm volatile("" : "+s"(nrep)); for (int rep = 0; rep < nrep; ++rep) xcd_barrier((unsigned*)(ws + WS_BAR), xcc, (volatile PG8_LAS unsigned*)(lds + pg8::STAGE_BYTES), my_tid(wid_s)); }
    }
}

extern "C" void kernel_launch(void* const* d_in, const int* in_sizes, int n_in, void* d_out, int out_size, void* d_ws, size_t ws_size, hipStream_t stream) {
    constexpr int LDS_BYTES = pg8::STAGE_BYTES + 16;
    static int grid = 0;
    if (grid == 0) {
        if (n_in != 17 || out_size != T_ * 1024 || ws_size < WS_END) { fprintf(stderr, "kernel_launch: unexpected shapes (n_in %d out %d ws %zu, need %zu)\n", n_in, out_size, ws_size, (size_t)WS_END); grid = -1; return; }
        int dev = 0, cus = 0, per_cu = 0;
        hipGetDevice(&dev);
        hipDeviceGetAttribute(&cus, hipDeviceAttributeMultiprocessorCount, dev);
        if (hipFuncSetAttribute((const void*)fwd_kernel, hipFuncAttributeMaxDynamicSharedMemorySize, LDS_BYTES) != hipSuccess) { fprintf(stderr, "kernel_launch: hipFuncSetAttribute failed\n"); grid = -1; return; }
        if (hipOccupancyMaxActiveBlocksPerMultiprocessor(&per_cu, (const void*)fwd_kernel, 512, LDS_BYTES) != hipSuccess || per_cu < 1) { fprintf(stderr, "kernel_launch: occupancy query says %d\n", per_cu); per_cu = 1; }
        (void)hipGetLastError();
        grid = cus * 1;
    }
    if (grid < 0) return;
    if (hipMemsetAsync((char*)d_ws + WS_BAR, 0, XCD_BAR_WORDS * sizeof(unsigned), stream) != hipSuccess) { fprintf(stderr, "kernel_launch: memset of the barrier words failed\n"); return; }
    Params p{};
    for (int i = 0; i < 17; ++i) p.in[i] = (const float*)d_in[i];
    p.out = (float*)d_out; p.ws = (unsigned char*)d_ws;
    void* args[] = {&p};
    hipError_t e = hipLaunchCooperativeKernel((const void*)fwd_kernel, dim3(grid), dim3(512), args, LDS_BYTES, stream);
    if (e != hipSuccess) fprintf(stderr, "cooperative launch failed: %s (grid %d)\n", hipGetErrorString(e), grid);
}
```
